# Optimizing an MI355X kernel written in HIP

```python
import math
import jax, jax.numpy as jnp
from jax import lax
import numpy as np

D_MODEL = 1024
BATCH = 8
SEQ = 2048
DEPTH = 1

D_CONF = D_MODEL // 2
D_SC = D_MODEL // 2
GROUP = 128
CONF_KERNEL = 31
SC_KERNEL = 3
N_BRANCH = 2
D_FF = int(math.ceil(8 * D_MODEL / 3 / 256) * 256)
D_IN = 2 * D_CONF + 3 * D_SC + N_BRANCH * D_MODEL
RMS_EPS = 1e-6
LN_EPS = 1e-5

kernel_name = "hybrid_conformer_shortconv_gated_adaln_block"


def _rmsnorm(x, g):
    xf = x.astype(jnp.float32)
    y = xf * lax.rsqrt(jnp.mean(xf * xf, axis=-1, keepdims=True) + RMS_EPS)
    return (y * g.astype(jnp.float32)).astype(x.dtype)


def _layernorm(x, g, b):
    xf = x.astype(jnp.float32)
    mu = jnp.mean(xf, axis=-1, keepdims=True)
    var = jnp.mean(jnp.square(xf - mu), axis=-1, keepdims=True)
    y = (xf - mu) * lax.rsqrt(var + LN_EPS)
    return (y * g.astype(jnp.float32) + b.astype(jnp.float32)).astype(x.dtype)


def _causal_dwconv(x, w):
    k, ch = w.shape
    rhs = w.astype(x.dtype)[:, None, :]
    return lax.conv_general_dilated(
        x, rhs, window_strides=(1,), padding=[(k - 1, 0)],
        dimension_numbers=("NWC", "WIO", "NWC"), feature_group_count=ch)


def _modulate(h, shift, scale):
    return h * (1.0 + scale[:, None, :]) + shift[:, None, :]


def setup_inputs(seed: int = 0) -> dict:
    key = jax.random.key(seed)
    ks = jax.random.split(key, 24)
    L, D = DEPTH, D_MODEL
    n = lambda k, shape, s: (jax.random.normal(k, shape, jnp.float32) * s)
    return {
        "x": n(ks[0], (BATCH, SEQ, D), 1.0),
        "c": n(ks[1], (BATCH, D), 1.0),
        "w_ada": n(ks[2], (L, D, 6 * D), 0.3 * D ** -0.5),
        "b_ada": n(ks[3], (L, 6 * D), 0.02),
        "norm1_g": 1.0 + n(ks[4], (L, D), 0.02),
        "w_in": n(ks[5], (L, D, D_IN), D ** -0.5),
        "b_glu": n(ks[6], (L, 2 * D_CONF), 0.02),
        "conf_dw_w": n(ks[7], (L, CONF_KERNEL, D_CONF), CONF_KERNEL ** -0.5),
        "conf_dw_b": n(ks[8], (L, D_CONF), 0.02),
        "conf_ln_g": 1.0 + n(ks[9], (L, D_CONF), 0.02),
        "conf_ln_b": n(ks[10], (L, D_CONF), 0.02),
        "conf_w_out": n(ks[11], (L, D_CONF, D), D_CONF ** -0.5),
        "conf_b_out": n(ks[12], (L, D), 0.02),
        "sc_dw_w": n(ks[13], (L, SC_KERNEL, D_SC), SC_KERNEL ** -0.5),
        "sc_w_out": n(ks[14], (L, D_SC, D), D_SC ** -0.5),
        "b_gate": n(ks[15], (L, N_BRANCH * D), 0.02),
        "w_o": n(ks[16], (L, D, D), D ** -0.5),
        "norm2_g": 1.0 + n(ks[17], (L, D), 0.02),
        "w_gu": n(ks[18], (L, D, 2 * D_FF), D ** -0.5),
        "w_down": n(ks[19], (L, D_FF, D), D_FF ** -0.5),
        "final_g": 1.0 + n(ks[20], (D,), 0.02),
    }


def reference(x, c, w_ada, b_ada, norm1_g, w_in, b_glu, conf_dw_w, conf_dw_b,
              conf_ln_g, conf_ln_b, conf_w_out, conf_b_out, sc_dw_w, sc_w_out,
              b_gate, w_o, norm2_g, w_gu, w_down, final_g):
    c_act = jax.nn.silu(c)
    for l in range(DEPTH):
        mod = c_act @ w_ada[l] + b_ada[l]
        sh1, sc1, gt1, sh2, sc2, gt2 = jnp.split(mod, 6, axis=-1)

        h = _modulate(_rmsnorm(x, norm1_g[l]), sh1, sc1)
        p = h @ w_in[l]
        conf_in, sc_in, gate_in = jnp.split(
            p, [2 * D_CONF, 2 * D_CONF + 3 * D_SC], axis=-1)

        u = conf_in + b_glu[l]
        u_a, u_b = jnp.split(u, 2, axis=-1)
        u = u_a * jax.nn.sigmoid(u_b)
        u = _causal_dwconv(u, conf_dw_w[l]) + conf_dw_b[l]
        u = jax.nn.silu(_layernorm(u, conf_ln_g[l], conf_ln_b[l]))
        y_a = u @ conf_w_out[l] + conf_b_out[l]

        g_b, g_c, v = jnp.split(sc_in, 3, axis=-1)
        v = g_b * _causal_dwconv(g_c * v, sc_dw_w[l])
        y_b = v @ sc_w_out[l]

        gates = jax.nn.sigmoid(gate_in + b_gate[l])
        ga, gb = jnp.split(gates, 2, axis=-1)
        mixed = (ga * y_a + gb * y_b) @ w_o[l]
        x = x + gt1[:, None, :] * mixed

        h2 = _modulate(_rmsnorm(x, norm2_g[l]), sh2, sc2)
        gu = h2 @ w_gu[l]
        f_g, f_u = jnp.split(gu, 2, axis=-1)
        ffn = (jax.nn.silu(f_g) * f_u) @ w_down[l]
        x = x + gt2[:, None, :] * ffn

    return _rmsnorm(x, final_g)
```

```cpp
#include <hip/hip_runtime.h>
#include <hip/hip_cooperative_groups.h>
#include <cstdio>
#include <cstdint>
namespace cg = cooperative_groups;

#ifndef PROBE_NOGATE
#define PROBE_NOGATE 0
#endif
#ifndef DUMP_SCALE
#define DUMP_SCALE 1.0f
#endif
#ifndef STOP_AFTER
#define STOP_AFTER 9
#endif
#ifndef MODE
#define MODE 2
#endif
#ifndef NAIVE_MASK
#define NAIVE_MASK 0
#endif

#define LAS __attribute__((address_space(3)))
typedef unsigned short bf16_t;
typedef short bf16x8 __attribute__((ext_vector_type(8)));
typedef float f32x4 __attribute__((ext_vector_type(4)));
typedef float f32x2 __attribute__((ext_vector_type(2)));
typedef unsigned u32x4 __attribute__((ext_vector_type(4)));
typedef unsigned u32x2 __attribute__((ext_vector_type(2)));

constexpr int NB = 8, SEQ = 2048, D = 1024, M = NB * SEQ, DC = 512, DIN = 4608, DFF = 2816, NGU = 2 * DFF, NMOD = 6 * D;
constexpr int CONF_K = 31;
constexpr float RMS_EPS = 1e-6f, LN_EPS = 1e-5f;
constexpr int MO_SH1 = 0, MO_SC1 = D, MO_GT1 = 2 * D, MO_SH2 = 3 * D, MO_SC2 = 4 * D, MO_GT2 = 5 * D;

constexpr size_t MiB = 1u << 20;
constexpr size_t WS_MOD = 1 * MiB;
constexpr size_t WS_WIN = 8 * MiB;
constexpr size_t WS_WA = 17 * MiB;
constexpr size_t WS_WB = 18 * MiB;
constexpr size_t WS_WO = 19 * MiB;
constexpr size_t WS_WGU = 21 * MiB;
constexpr size_t WS_WDN = 32 * MiB;
constexpr size_t WS_A1 = 40 * MiB;
constexpr size_t WS_UA = 40 * MiB, WS_VB = 56 * MiB;
constexpr size_t WS_U = 72 * MiB, WS_GCV = 88 * MiB, WS_GB = 104 * MiB;
constexpr size_t WS_GATES = 120 * MiB;
constexpr size_t WS_T = 72 * MiB;
constexpr size_t WS_ACT = 72 * MiB;
constexpr size_t WS_X1 = 160 * MiB;
constexpr size_t WS_MIX = 224 * MiB;
constexpr size_t WS_END = 256 * MiB;

constexpr int LDS_BYTES = 131072 + 2048;

struct Args {
    const float *x, *c, *w_ada, *b_ada, *norm1_g, *w_in, *b_glu, *conf_dw_w, *conf_dw_b, *conf_ln_g, *conf_ln_b, *conf_w_out, *conf_b_out,
        *sc_dw_w, *sc_w_out, *b_gate, *w_o, *norm2_g, *w_gu, *w_down, *final_g;
    float* out; unsigned char* ws; int ph_lo, ph_hi;
};

__device__ __forceinline__ float bf_lo(unsigned v) { return __uint_as_float(v << 16); }
__device__ __forceinline__ float bf_hi(unsigned v) { return __uint_as_float(v & 0xffff0000u); }
__device__ __forceinline__ float bf2f(bf16_t v) { return __uint_as_float(((unsigned)v) << 16); }
typedef __bf16 bf16x2_t __attribute__((ext_vector_type(2)));
__device__ __forceinline__ unsigned cvt_pk_bf16(float lo, float hi) { const f32x2 v = {lo, hi}; const bf16x2_t b = __builtin_convertvector(v, bf16x2_t); return __builtin_bit_cast(unsigned, b); }
__device__ __forceinline__ bf16_t f2bf(float f) { return (bf16_t)(cvt_pk_bf16(f, 0.f) & 0xffffu); }
__device__ __forceinline__ u32x4 pack8(const f32x4 a, const f32x4 b) { u32x4 w; w.x = cvt_pk_bf16(a[0], a[1]); w.y = cvt_pk_bf16(a[2], a[3]); w.z = cvt_pk_bf16(b[0], b[1]); w.w = cvt_pk_bf16(b[2], b[3]); return w; }
__device__ __forceinline__ void unpack8(const u32x4 w, f32x4& a, f32x4& b) { a[0] = bf_lo(w.x); a[1] = bf_hi(w.x); a[2] = bf_lo(w.y); a[3] = bf_hi(w.y); b[0] = bf_lo(w.z); b[1] = bf_hi(w.z); b[2] = bf_lo(w.w); b[3] = bf_hi(w.w); }
__device__ __forceinline__ float sigm(float x) { return __builtin_amdgcn_rcpf(1.0f + __builtin_amdgcn_exp2f(-1.4426950408889634f * x)); }
__device__ __forceinline__ int opaque_tid() { int t = threadIdx.x; asm volatile("" : "+v"(t)); return t; }
__device__ __forceinline__ float wave_sum(float v) {
#pragma unroll
    for (int o = 1; o < 64; o <<= 1) v += __shfl_xor(v, o);
    return v;
}
__device__ __forceinline__ int map_in(int r) {
    const int t = r >> 8, j = r & 255, h = j >> 7, jj = j & 127;
    if (t < 4) return h * 512 + 128 * t + jj;
    if (t < 6) return 1024 + 256 * (t - 4) + j;
    if (t < 10) return (h ? 2048 : 1536) + 128 * (t - 6) + jj;
    return 2560 + 256 * (t - 10) + j;
}
__device__ __forceinline__ int map_gu(int r) { const int t = r >> 8, j = r & 255, h = j >> 7, jj = j & 127; return h * DFF + 128 * t + jj; }

namespace pg8 {
constexpr int BM = 256, BK = 64, HALF = 128, HTB = HALF * BK * 2, STAGE_BYTES = 8 * HTB, NXCD = 8, WGM = 8;
__device__ __forceinline__ int lds_byte(int r, int c) { const int st = (r >> 4) * 2 + (c >> 5), rr = r & 15, cc = c & 31, ob = rr * 64 + cc * 2; return st * 1024 + (ob ^ (((ob >> 9) & 1) << 5)); }
__device__ __forceinline__ void stage_rc(int b, int& R, int& C) { const int st = b / 1024, sb = b % 1024, swz = sb ^ (((sb >> 9) & 1) << 5); R = (st >> 1) * 16 + swz / 64; C = (st & 1) * 32 + (swz % 64) / 2; }
__device__ __forceinline__ int perm32(int rho) { const int n = rho >> 4, i = rho & 15; return 8 * (i >> 2) + 4 * n + (i & 3); }

struct Unit { int pm, pn, sel; };
struct Gemm { const bf16_t *A0, *B0, *A1, *B1; int K; };

struct Order {
    int nM, nN, nwg, G, c, dual;
    __device__ void init(int M_, int N_, int G_, int c_, int dual_) { nM = M_ / BM; nN = N_ / BM; nwg = nM * nN; G = G_; c = c_; dual = dual_; }
    __device__ bool next(int i, Unit& u) const {
        const int ii = dual ? (i >> 1) : i;
        const long L = (long)ii * G + c; if (L >= nwg) return false;
        int wgid = (int)L; { const int q = nwg / NXCD, r = nwg % NXCD, xcd = wgid % NXCD, off = wgid / NXCD; wgid = (xcd < r ? xcd * (q + 1) : r * (q + 1) + (xcd - r) * q) + off; }
        const int nig = WGM * nN, gid = wgid / nig, fm = gid * WGM, gsz = (nM - fm) < WGM ? (nM - fm) : WGM;
        u.pm = fm + ((wgid % nig) % gsz); u.pn = (wgid % nig) / gsz; u.sel = dual ? (i & 1) : 0; return true;
    }
};

template <class Epi>
__device__ __forceinline__ void gemm_phase(LAS unsigned char* lds, const Gemm g, const Order& S, const Epi& E) {
    const int tid = opaque_tid(), wid = __builtin_amdgcn_readfirstlane(tid >> 6), lane = tid & 63, wr = wid >> 2, wc = wid & 3, fr = lane & 15, fq = lane >> 4;
    const int K = g.K, nt = K / BK;
    unsigned voffA[2], voffB[2];
#pragma unroll
    for (int i = 0; i < 2; ++i) { int R, C; stage_rc(tid * 16 + i * 8192, R, C); const int Rb = (R & ~31) + perm32(R & 31);
        voffA[i] = (unsigned)(R * K + C) * 2u; voffB[i] = (unsigned)(Rb * K + C) * 2u; }
    const size_t kstep = (size_t)(BK * 2);
    const size_t hstep = (size_t)HALF * K * 2;
    const size_t tstep = 2 * hstep;
    const unsigned ldsw = (unsigned)wid * 1024u;
    const int aoff = lds_byte(wr * 64 + fr, fq * 8), boff = lds_byte(wc * 32 + fr, fq * 8);
#define PG8_SA(b, h) (((b) * 2 + (h)) * HTB)
#define PG8_SB(b, h) ((4 + (b) * 2 + (h)) * HTB)
#define PG8_STAGE(bufoff, gbase, voff) do { _Pragma("unroll") for (int _i = 0; _i < 2; ++_i) \
        __builtin_amdgcn_global_load_lds((const unsigned*)((const char*)(gbase) + (voff)[_i]), (LAS unsigned*)(lds + (bufoff) + ldsw + _i * 8192), 16, 0, 0); } while (0)
#define PG8_LDA(dst, b, h) do { _Pragma("unroll") for (int m = 0; m < 4; ++m) _Pragma("unroll") for (int k = 0; k < 2; ++k) dst[m][k] = *(const LAS bf16x8*)(lds + PG8_SA(b, h) + aoff + m * 2048 + k * 1024); } while (0)
#define PG8_LDB(dst, b, h) do { _Pragma("unroll") for (int n = 0; n < 2; ++n) _Pragma("unroll") for (int k = 0; k < 2; ++k) dst[n][k] = *(const LAS bf16x8*)(lds + PG8_SB(b, h) + boff + n * 2048 + k * 1024); } while (0)
#define PG8_MMA(ai, bj, At, Bt) do { __builtin_amdgcn_s_setprio(1); _Pragma("unroll") for (int m = 0; m < 4; ++m) _Pragma("unroll") for (int n = 0; n < 2; ++n) _Pragma("unroll") for (int k = 0; k < 2; ++k) \
        acc[ai][bj][m][n] = __builtin_amdgcn_mfma_f32_16x16x32_bf16(Bt[n][k], At[m][k], acc[ai][bj][m][n], 0, 0, 0); __builtin_amdgcn_s_setprio(0); } while (0)
#define PG8_WAIT_V(n) asm volatile("s_waitcnt vmcnt(" #n ")" ::: "memory")
#define PG8_WAIT_L(n) asm volatile("s_waitcnt lgkmcnt(" #n ")" ::: "memory")
#define PG8_BAR __builtin_amdgcn_s_barrier()
#define PG8_SCHED __builtin_amdgcn_sched_barrier(0)
    Unit cur, nxt; int ui = 0;
    if (!S.next(0, cur)) return;
    f32x4 acc[2][2][4][2];
#pragma unroll
    for (int a = 0; a < 2; ++a)
#pragma unroll
        for (int b = 0; b < 2; ++b)
#pragma unroll
            for (int m = 0; m < 4; ++m)
#pragma unroll
                for (int n = 0; n < 2; ++n) acc[a][b][m][n] = (f32x4){0.f, 0.f, 0.f, 0.f};
    bf16x8 At[4][2], B0[2][2], B1[2][2];
    const char* cA = (const char*)(cur.sel ? g.A1 : g.A0) + (size_t)cur.pm * tstep; const char* cB = (const char*)(cur.sel ? g.B1 : g.B0) + (size_t)cur.pn * tstep;
    PG8_STAGE(PG8_SB(0, 0), cB, voffB); PG8_STAGE(PG8_SB(0, 1), cB + hstep, voffB); PG8_STAGE(PG8_SA(0, 0), cA, voffA); PG8_STAGE(PG8_SA(0, 1), cA + hstep, voffA);
    if (wr == 1) PG8_BAR;
    PG8_WAIT_V(2); PG8_BAR;
    PG8_STAGE(PG8_SB(1, 0), cB + kstep, voffB); PG8_STAGE(PG8_SA(1, 0), cA + kstep, voffA); PG8_STAGE(PG8_SB(1, 1), cB + hstep + kstep, voffB);
    PG8_WAIT_V(6); PG8_BAR;
    for (;;) {
        const bool has_next = S.next(ui + 1, nxt);
        const char* nA = has_next ? (const char*)(nxt.sel ? g.A1 : g.A0) + (size_t)nxt.pm * tstep : cA; const char* nB = has_next ? (const char*)(nxt.sel ? g.B1 : g.B0) + (size_t)nxt.pn * tstep : cB;
        for (int t = 0; t < nt; t += 2) {
            const bool last = (t == nt - 2);
            const char* a1 = cA + (size_t)(t + 1) * kstep;
            const char* a2 = last ? nA : cA + (size_t)(t + 2) * kstep; const char* b2 = last ? nB : cB + (size_t)(t + 2) * kstep;
            const char* a3 = a2 + kstep; const char* b3 = b2 + kstep;
            PG8_LDB(B0, 0, 0); PG8_LDB(B1, 0, 1); PG8_SCHED; PG8_LDA(At, 0, 0); PG8_STAGE(PG8_SA(1, 1), a1 + hstep, voffA);
            PG8_WAIT_V(8); PG8_WAIT_L(0); PG8_BAR; PG8_MMA(0, 0, At, B0); PG8_MMA(0, 1, At, B1); PG8_BAR; PG8_SCHED;
            PG8_LDA(At, 0, 1); PG8_STAGE(PG8_SB(0, 0), b2, voffB); PG8_STAGE(PG8_SB(0, 1), b2 + hstep, voffB); PG8_STAGE(PG8_SA(0, 0), a2, voffA);
            PG8_WAIT_V(8); PG8_WAIT_L(0); PG8_BAR; PG8_MMA(1, 0, At, B0); PG8_MMA(1, 1, At, B1); PG8_BAR; PG8_SCHED;
            PG8_LDB(B0, 1, 0); PG8_LDB(B1, 1, 1); PG8_SCHED; PG8_LDA(At, 1, 0); PG8_STAGE(PG8_SA(0, 1), a2 + hstep, voffA);
            PG8_WAIT_V(8); PG8_WAIT_L(0); PG8_BAR; PG8_MMA(0, 0, At, B0); PG8_MMA(0, 1, At, B1); PG8_BAR; PG8_SCHED;
            PG8_LDA(At, 1, 1); PG8_STAGE(PG8_SB(1, 0), b3, voffB); PG8_STAGE(PG8_SB(1, 1), b3 + hstep, voffB); PG8_STAGE(PG8_SA(1, 0), a3, voffA);
            PG8_WAIT_V(8); PG8_WAIT_L(0); PG8_BAR; PG8_MMA(1, 0, At, B0); PG8_MMA(1, 1, At, B1); PG8_BAR; PG8_SCHED;
        }
        if (wr == 0) PG8_BAR;
        E(acc, cur, wr, wc, fr, fq);
        if (!has_next) break;
#pragma unroll
        for (int a = 0; a < 2; ++a)
#pragma unroll
            for (int b = 0; b < 2; ++b)
#pragma unroll
                for (int m = 0; m < 4; ++m)
#pragma unroll
                    for (int n = 0; n < 2; ++n) acc[a][b][m][n] = (f32x4){0.f, 0.f, 0.f, 0.f};
        cur = nxt; cA = nA; cB = nB; ++ui;
        if (wr == 1) PG8_BAR;
    }
    PG8_WAIT_V(0);
    PG8_BAR;
#undef PG8_SA
#undef PG8_SB
#undef PG8_STAGE
#undef PG8_LDA
#undef PG8_LDB
#undef PG8_MMA
#undef PG8_WAIT_V
#undef PG8_WAIT_L
#undef PG8_BAR
#undef PG8_SCHED
}
}

typedef const f32x4 (&AccRef)[2][2][4][2];
struct EpiIn {
    bf16_t *U, *GB, *GCV, *GATES; const float *b_glu, *b_gate;
    __device__ __forceinline__ void operator()(AccRef acc, const pg8::Unit& u, int wr, int wc, int fr, int fq) const {
        const int row0 = u.pm * 256 + wr * 64 + fr, t = u.pn, cw = wc * 32 + fq * 8;
        if (t < 4) {
            const int cA = 128 * t + cw; f32x4 ba[2], bb[2];
#pragma unroll
            for (int n = 0; n < 2; ++n) { ba[n] = *(const f32x4*)(b_glu + cA + 4 * n); bb[n] = *(const f32x4*)(b_glu + 512 + cA + 4 * n); }
#pragma unroll
            for (int ai = 0; ai < 2; ++ai)
#pragma unroll
                for (int m = 0; m < 4; ++m) { f32x4 r[2];
#pragma unroll
                    for (int n = 0; n < 2; ++n) { const f32x4 a = acc[ai][0][m][n] + ba[n], b = acc[ai][1][m][n] + bb[n];
#pragma unroll
                        for (int j = 0; j < 4; ++j) r[n][j] = a[j] * sigm(b[j]); }
                    *(u32x4*)(U + (size_t)(row0 + ai * 128 + m * 16) * DC + cA) = pack8(r[0], r[1]); }
        } else if (t < 6) {
            const int c0 = 256 * (t - 4) + cw;
#pragma unroll
            for (int ai = 0; ai < 2; ++ai)
#pragma unroll
                for (int m = 0; m < 4; ++m)
#pragma unroll
                    for (int bj = 0; bj < 2; ++bj) *(u32x4*)(GB + (size_t)(row0 + ai * 128 + m * 16) * DC + c0 + 128 * bj) = pack8(acc[ai][bj][m][0], acc[ai][bj][m][1]);
        } else if (t < 10) {
            const int cA = 128 * (t - 6) + cw;
#pragma unroll
            for (int ai = 0; ai < 2; ++ai)
#pragma unroll
                for (int m = 0; m < 4; ++m)
                    *(u32x4*)(GCV + (size_t)(row0 + ai * 128 + m * 16) * DC + cA) = pack8(acc[ai][0][m][0] * acc[ai][1][m][0], acc[ai][0][m][1] * acc[ai][1][m][1]);
        } else {
            const int c0 = 256 * (t - 10) + cw; f32x4 bv[2][2];
#pragma unroll
            for (int bj = 0; bj < 2; ++bj)
#pragma unroll
                for (int n = 0; n < 2; ++n) bv[bj][n] = *(const f32x4*)(b_gate + c0 + 128 * bj + 4 * n);
#pragma unroll
            for (int ai = 0; ai < 2; ++ai)
#pragma unroll
                for (int m = 0; m < 4; ++m)
#pragma unroll
                    for (int bj = 0; bj < 2; ++bj) { f32x4 r[2];
#pragma unroll
                        for (int n = 0; n < 2; ++n) { const f32x4 a = acc[ai][bj][m][n] + bv[bj][n];
#pragma unroll
                            for (int j = 0; j < 4; ++j) r[n][j] = sigm(a[j]); }
                        *(u32x4*)(GATES + (size_t)(row0 + ai * 128 + m * 16) * 2048 + c0 + 128 * bj) = pack8(r[0], r[1]); }
        }
    }
};
struct EpiDual {
    bf16_t *T, *MIX; const bf16_t* GATES; const float* b_out; int mode;
    __device__ __forceinline__ void operator()(AccRef acc, const pg8::Unit& u, int wr, int wc, int fr, int fq) const {
        const int row0 = u.pm * 256 + wr * 64 + fr, c0 = 256 * u.pn + wc * 32 + fq * 8;
        if (mode == 0) {
            f32x4 bv[2][2];
#pragma unroll
            for (int bj = 0; bj < 2; ++bj)
#pragma unroll
                for (int n = 0; n < 2; ++n) bv[bj][n] = *(const f32x4*)(b_out + c0 + 128 * bj + 4 * n);
#pragma unroll
            for (int ai = 0; ai < 2; ++ai)
#pragma unroll
                for (int m = 0; m < 4; ++m) { const size_t row = (size_t)(row0 + ai * 128 + m * 16);
#pragma unroll
                    for (int bj = 0; bj < 2; ++bj) { f32x4 g0, g1; unpack8(*(const u32x4*)(GATES + row * 2048 + c0 + 128 * bj), g0, g1);
                        if (PROBE_NOGATE) { g0 = (f32x4){1.f, 1.f, 1.f, 1.f}; g1 = g0; }
                        *(u32x4*)(T + row * D + c0 + 128 * bj) = pack8(g0 * (acc[ai][bj][m][0] + bv[bj][0]), g1 * (acc[ai][bj][m][1] + bv[bj][1])); }
                    asm volatile("" ::: "memory"); }
        } else {
#pragma unroll
            for (int ai = 0; ai < 2; ++ai)
#pragma unroll
                for (int m = 0; m < 4; ++m) { const size_t row = (size_t)(row0 + ai * 128 + m * 16);
#pragma unroll
                    for (int bj = 0; bj < 2; ++bj) { f32x4 g0, g1, t0, t1; unpack8(*(const u32x4*)(GATES + row * 2048 + 1024 + c0 + 128 * bj), g0, g1);
                        unpack8(*(const u32x4*)(T + row * D + c0 + 128 * bj), t0, t1);
                        *(u32x4*)(MIX + row * D + c0 + 128 * bj) = pack8(t0 + g0 * acc[ai][bj][m][0], t1 + g1 * acc[ai][bj][m][1]); }
                    asm volatile("" ::: "memory"); }
        }
    }
};
struct EpiRes {
    const float* xin; float* xout; const float* gt; float scale;
    __device__ __forceinline__ void operator()(AccRef acc, const pg8::Unit& u, int wr, int wc, int fr, int fq) const {
        const int row0 = u.pm * 256 + wr * 64 + fr, c0 = 256 * u.pn + wc * 32 + fq * 8, b = u.pm >> 3; f32x4 gv[2][2];
#pragma unroll
        for (int bj = 0; bj < 2; ++bj)
#pragma unroll
            for (int n = 0; n < 2; ++n) gv[bj][n] = *(const f32x4*)(gt + (size_t)b * NMOD + c0 + 128 * bj + 4 * n);
        f32x4 cur[2][2], nxt[2][2];
        { const size_t off = (size_t)row0 * D + c0;
#pragma unroll
          for (int bj = 0; bj < 2; ++bj)
#pragma unroll
              for (int n = 0; n < 2; ++n) cur[bj][n] = *(const f32x4*)(xin + off + 128 * bj + 4 * n); }
#pragma unroll
        for (int g = 0; g < 8; ++g) { const int ai = g >> 2, m = g & 3;
            if (g < 7) { const size_t offn = (size_t)(row0 + ((g + 1) >> 2) * 128 + ((g + 1) & 3) * 16) * D + c0;
#pragma unroll
                for (int bj = 0; bj < 2; ++bj)
#pragma unroll
                    for (int n = 0; n < 2; ++n) nxt[bj][n] = *(const f32x4*)(xin + offn + 128 * bj + 4 * n); }
            const size_t off = (size_t)(row0 + ai * 128 + m * 16) * D + c0;
#pragma unroll
            for (int bj = 0; bj < 2; ++bj)
#pragma unroll
                for (int n = 0; n < 2; ++n) *(f32x4*)(xout + off + 128 * bj + 4 * n) = cur[bj][n] + gv[bj][n] * acc[ai][bj][m][n] * scale;
#pragma unroll
            for (int bj = 0; bj < 2; ++bj)
#pragma unroll
                for (int n = 0; n < 2; ++n) cur[bj][n] = nxt[bj][n];
            asm volatile("" ::: "memory"); }
    }
};
struct EpiGU {
    bf16_t* ACT;
    __device__ __forceinline__ void operator()(AccRef acc, const pg8::Unit& u, int wr, int wc, int fr, int fq) const {
        const int row0 = u.pm * 256 + wr * 64 + fr, cA = 128 * u.pn + wc * 32 + fq * 8;
#pragma unroll
        for (int ai = 0; ai < 2; ++ai)
#pragma unroll
            for (int m = 0; m < 4; ++m) { f32x4 r[2];
#pragma unroll
                for (int n = 0; n < 2; ++n) { const f32x4 a = acc[ai][0][m][n], b = acc[ai][1][m][n];
#pragma unroll
                    for (int j = 0; j < 4; ++j) r[n][j] = a[j] * sigm(a[j]) * b[j]; }
                *(u32x4*)(ACT + (size_t)(row0 + ai * 128 + m * 16) * DFF + cA) = pack8(r[0], r[1]); }
    }
};

__device__ __forceinline__ void p0_mod(const Args& a, float* mod, LAS unsigned char* lds, int item, int tid, int lane, int wave) {
    LAS float* cs = (LAS float*)lds; LAS float* red = (LAS float*)(lds + 32768);
    for (int i = tid; i < NB * D; i += 512) { const int b = i >> 10, k = i & 1023; const float v = a.c[i]; cs[k * 8 + b] = v * sigm(v); }
    __syncthreads();
    const int jl = lane & 31, j = item * 32 + jl, kg = wave * 2 + (lane >> 5);
    float s0 = 0.f, s1 = 0.f, s2 = 0.f, s3 = 0.f, s4 = 0.f, s5 = 0.f, s6 = 0.f, s7 = 0.f;
#pragma unroll 8
    for (int kk = 0; kk < 64; ++kk) { const int k = kg * 64 + kk; const float w = a.w_ada[(size_t)k * NMOD + j];
        const f32x4 c0 = *(const LAS f32x4*)(cs + k * 8), c1 = *(const LAS f32x4*)(cs + k * 8 + 4);
        s0 += w * c0[0]; s1 += w * c0[1]; s2 += w * c0[2]; s3 += w * c0[3]; s4 += w * c1[0]; s5 += w * c1[1]; s6 += w * c1[2]; s7 += w * c1[3]; }
    red[(kg * 8 + 0) * 32 + jl] = s0; red[(kg * 8 + 1) * 32 + jl] = s1; red[(kg * 8 + 2) * 32 + jl] = s2; red[(kg * 8 + 3) * 32 + jl] = s3;
    red[(kg * 8 + 4) * 32 + jl] = s4; red[(kg * 8 + 5) * 32 + jl] = s5; red[(kg * 8 + 6) * 32 + jl] = s6; red[(kg * 8 + 7) * 32 + jl] = s7;
    __syncthreads();
    if (tid < 256) { const int b = tid >> 5, jj = tid & 31; float s = 0.f;
#pragma unroll
        for (int g = 0; g < 16; ++g) s += red[(g * 8 + b) * 32 + jj];
        mod[(size_t)b * NMOD + item * 32 + jj] = s + a.b_ada[item * 32 + jj]; }
    __syncthreads();
}
__device__ __forceinline__ void transpose_item(const float* W, int K, int N, bf16_t* WT, int k0, int nsrc0, int rdst0, LAS float* scr, int lane) {
#pragma unroll 8
    for (int i = 0; i < 32; ++i) { const int kk = 2 * i + (lane >> 5); scr[kk * 33 + (lane & 31)] = W[(size_t)(k0 + kk) * N + nsrc0 + (lane & 31)]; }
    asm volatile("s_waitcnt lgkmcnt(0)" ::: "memory");
    const int c = lane & 7;
#pragma unroll
    for (int j = 0; j < 4; ++j) { const int n = (lane >> 3) + 8 * j; const LAS float* s = scr + (8 * c) * 33 + n;
        u32x4 o; o.x = cvt_pk_bf16(s[0 * 33], s[1 * 33]); o.y = cvt_pk_bf16(s[2 * 33], s[3 * 33]); o.z = cvt_pk_bf16(s[4 * 33], s[5 * 33]); o.w = cvt_pk_bf16(s[6 * 33], s[7 * 33]);
        *(u32x4*)(WT + (size_t)(rdst0 + n) * K + k0 + 8 * c) = o; }
    asm volatile("s_waitcnt lgkmcnt(0)" ::: "memory");
}
__device__ __forceinline__ void p0_convert(const Args& a, unsigned char* ws, LAS unsigned char* lds, int gw, int NGW, int wave, int lane) {
    LAS float* scr = (LAS float*)(lds + 49152 + wave * 8448);
    constexpr int I_IN = (D / 64) * (DIN / 32), I_A = (DC / 64) * (D / 32), I_B = I_A, I_O = (D / 64) * (D / 32), I_GU = (D / 64) * (NGU / 32), I_DN = (DFF / 64) * (D / 32);
    constexpr int NITEMS = I_IN + I_A + I_B + I_O + I_GU + I_DN;
    for (int it = gw; it < NITEMS; it += NGW) {
        int r = it;
        if (r < I_IN) { const int nblk = DIN / 32, kb = r / nblk, nb = r % nblk; transpose_item(a.w_in, D, DIN, (bf16_t*)(ws + WS_WIN), 64 * kb, map_in(32 * nb), 32 * nb, scr, lane); continue; } r -= I_IN;
        if (r < I_A) { const int nblk = D / 32, kb = r / nblk, nb = r % nblk; transpose_item(a.conf_w_out, DC, D, (bf16_t*)(ws + WS_WA), 64 * kb, 32 * nb, 32 * nb, scr, lane); continue; } r -= I_A;
        if (r < I_B) { const int nblk = D / 32, kb = r / nblk, nb = r % nblk; transpose_item(a.sc_w_out, DC, D, (bf16_t*)(ws + WS_WB), 64 * kb, 32 * nb, 32 * nb, scr, lane); continue; } r -= I_B;
        if (r < I_O) { const int nblk = D / 32, kb = r / nblk, nb = r % nblk; transpose_item(a.w_o, D, D, (bf16_t*)(ws + WS_WO), 64 * kb, 32 * nb, 32 * nb, scr, lane); continue; } r -= I_O;
        if (r < I_GU) { const int nblk = NGU / 32, kb = r / nblk, nb = r % nblk; transpose_item(a.w_gu, D, NGU, (bf16_t*)(ws + WS_WGU), 64 * kb, map_gu(32 * nb), 32 * nb, scr, lane); continue; } r -= I_GU;
        { const int nblk = D / 32, kb = r / nblk, nb = r % nblk; transpose_item(a.w_down, DFF, D, (bf16_t*)(ws + WS_WDN), 64 * kb, 32 * nb, 32 * nb, scr, lane); }
    }
}
__device__ __forceinline__ int own_row(int i, int wave, int G, int c) { return (G == 256) ? (c & 7) * SEQ + (c >> 3) * 64 + wave * 8 + i : (c * 8 + wave) + i * (G * 8); }
__device__ __forceinline__ int own_cnt(int G) { return (G == 256) ? 8 : (M + G * 8 - 1) / (G * 8); }
__device__ __forceinline__ void rownorm_mod(const float* X, const float* g, const float* mod, int sh_off, int sc_off, bf16_t* out, int wave, int G, int lane, int vid) {
    for (int it = 0; it < own_cnt(G); ++it) { const int m = own_row(it, wave, G, vid); if (m >= M) break;
        const int b = m >> 11; const f32x4* xr = (const f32x4*)(X + (size_t)m * D) + lane; f32x4 v[4]; float ss = 0.f;
#pragma unroll
        for (int j = 0; j < 4; ++j) { v[j] = xr[64 * j]; ss += (v[j][0] * v[j][0] + v[j][1] * v[j][1]) + (v[j][2] * v[j][2] + v[j][3] * v[j][3]); }
        const float rstd = rsqrtf(wave_sum(ss) * (1.f / D) + RMS_EPS);
        u32x2* o8 = (u32x2*)(out + (size_t)m * D) + lane;
#pragma unroll
        for (int j = 0; j < 4; ++j) { const int col = 4 * lane + 256 * j; const f32x4 gv = *(const f32x4*)(g + col), sc = *(const f32x4*)(mod + (size_t)b * NMOD + sc_off + col), sh = *(const f32x4*)(mod + (size_t)b * NMOD + sh_off + col);
            const f32x4 o = v[j] * rstd * gv * (sc + 1.0f) + sh; u32x2 w; w.x = cvt_pk_bf16(o[0], o[1]); w.y = cvt_pk_bf16(o[2], o[3]); o8[64 * j] = w; }
    }
}
__device__ __forceinline__ void final_norm(const float* X, float* O, const float* g, int wave, int G, int lane, int vid) {
    for (int it = 0; it < own_cnt(G); ++it) { const int m = own_row(it, wave, G, vid); if (m >= M) break;
        const f32x4* xr = (const f32x4*)(X + (size_t)m * D) + lane; f32x4* orow = (f32x4*)(O + (size_t)m * D) + lane; f32x4 v[4]; float ss = 0.f;
#pragma unroll
        for (int j = 0; j < 4; ++j) { v[j] = xr[64 * j]; ss += (v[j][0] * v[j][0] + v[j][1] * v[j][1]) + (v[j][2] * v[j][2] + v[j][3] * v[j][3]); }
        const float rstd = rsqrtf(wave_sum(ss) * (1.f / D) + RMS_EPS);
#pragma unroll
        for (int j = 0; j < 4; ++j) { const f32x4 gv = *(const f32x4*)(g + 4 * lane + 256 * j); orow[64 * j] = v[j] * rstd * gv; }
    }
}
__device__ __forceinline__ void p3_conv(const Args& a, unsigned char* ws, LAS unsigned char* lds, int tid, int lane, int wave, int vid) {
    const bf16_t* U = (const bf16_t*)(ws + WS_U); const unsigned* GCV = (const unsigned*)(ws + WS_GCV); const unsigned* GBp = (const unsigned*)(ws + WS_GB);
    unsigned* UA = (unsigned*)(ws + WS_UA); unsigned* VB = (unsigned*)(ws + WS_VB);
    LAS unsigned* buf = (LAS unsigned*)lds; LAS float* red = (LAS float*)(lds + 94 * 1024);
    const int cp = tid & 255, th = tid >> 8, w4 = wave & 3;
    f32x2 w[CONF_K];
#pragma unroll
    for (int k = 0; k < CONF_K; ++k) w[k] = *(const f32x2*)(a.conf_dw_w + k * DC + 2 * cp);
    const f32x2 cb = *(const f32x2*)(a.conf_dw_b + 2 * cp), lg = *(const f32x2*)(a.conf_ln_g + 2 * cp), lb = *(const f32x2*)(a.conf_ln_b + 2 * cp);
    const f32x2 w30 = *(const f32x2*)(a.sc_dw_w + 2 * cp), w31 = *(const f32x2*)(a.sc_dw_w + DC + 2 * cp), w32 = *(const f32x2*)(a.sc_dw_w + 2 * DC + 2 * cp);
    for (int tl = vid; tl < M / 64; tl += gridDim.x) {
        const int tile = (gridDim.x == 256) ? (tl & 7) * 32 + (tl >> 3) : tl;
        const int t0 = tile * 64, s0 = t0 & (SEQ - 1);
        __syncthreads();
        for (int ch = tid; ch < 94 * 64; ch += 512) { const int row = ch >> 6, c16 = ch & 63; u32x4 v = (u32x4){0u, 0u, 0u, 0u};
            if (s0 != 0 || row >= 30) v = *(const u32x4*)(U + (size_t)(t0 - 30 + row) * DC + c16 * 8);
            *(LAS u32x4*)(lds + row * 1024 + c16 * 16) = v; }
        __syncthreads();
#pragma unroll 1
        for (int chunk = 0; chunk < 4; ++chunk) {
            float y0[8], y1[8];
#pragma unroll
            for (int tt = 0; tt < 8; ++tt) { const int lt = th * 32 + chunk * 8 + tt; float a0 = cb[0], a1 = cb[1];
#pragma unroll
                for (int k = 0; k < CONF_K; ++k) { const unsigned v = buf[(lt + k) * 256 + cp]; a0 += w[k][0] * bf_lo(v); a1 += w[k][1] * bf_hi(v); }
                y0[tt] = a0; y1[tt] = a1; }
#pragma unroll
            for (int tt = 0; tt < 8; ++tt) { const float s = wave_sum(y0[tt] + y1[tt]), q = wave_sum(y0[tt] * y0[tt] + y1[tt] * y1[tt]);
                if (lane == 0) { red[((tt * 2 + th) * 4 + w4) * 2 + 0] = s; red[((tt * 2 + th) * 4 + w4) * 2 + 1] = q; } }
            __syncthreads();
#pragma unroll
            for (int tt = 0; tt < 8; ++tt) { const int lt = th * 32 + chunk * 8 + tt; const LAS float* r = red + (tt * 2 + th) * 8;
                const float S = (r[0] + r[2]) + (r[4] + r[6]), Q = (r[1] + r[3]) + (r[5] + r[7]);
                const float mean = S * (1.f / DC), var = fmaxf(Q * (1.f / DC) - mean * mean, 0.f), rstd = rsqrtf(var + LN_EPS);
                const float z0 = (y0[tt] - mean) * rstd * lg[0] + lb[0], z1 = (y1[tt] - mean) * rstd * lg[1] + lb[1];
                UA[(size_t)(t0 + lt) * (DC / 2) + cp] = cvt_pk_bf16(z0 * sigm(z0), z1 * sigm(z1)); }
            __syncthreads();
        }
        {
            const int tf = t0 + th * 32; unsigned p2 = 0u, p1 = 0u;
            if ((tf & (SEQ - 1)) != 0) { p2 = GCV[(size_t)(tf - 2) * (DC / 2) + cp]; p1 = GCV[(size_t)(tf - 1) * (DC / 2) + cp]; }
#pragma unroll 4
            for (int tt = 0; tt < 32; ++tt) { const size_t idx = (size_t)(tf + tt) * (DC / 2) + cp; const unsigned cur = GCV[idx], gb = GBp[idx];
                const float r0 = w30[0] * bf_lo(p2) + w31[0] * bf_lo(p1) + w32[0] * bf_lo(cur), r1 = w30[1] * bf_hi(p2) + w31[1] * bf_hi(p1) + w32[1] * bf_hi(cur);
                VB[idx] = cvt_pk_bf16(bf_lo(gb) * r0, bf_hi(gb) * r1); p2 = p1; p1 = cur; }
        }
    }
}

template <int LO, int HI>
__device__ __forceinline__ void mega_body(const Args& a) {
    extern __shared__ __attribute__((aligned(16))) unsigned char lds_raw[];
    LAS unsigned char* lds = (LAS unsigned char*)lds_raw;
    const int G = gridDim.x;
#define PHASE_IDS const int tid = opaque_tid(), lane = tid & 63, wave = __builtin_amdgcn_readfirstlane(tid >> 6); (void)tid; (void)lane; (void)wave
    unsigned char* ws = a.ws; float* mod = (float*)(ws + WS_MOD);
    constexpr int lo = LO, hi = HI;
#define IN(k) (lo <= (k) && (k) < hi)
#define GRID_BARRIER(idx) do { asm volatile("s_waitcnt vmcnt(0) lgkmcnt(0)" ::: "memory"); __syncthreads(); \
        if (threadIdx.x == 0) { unsigned* bw = (unsigned*)a.ws + 1024 + 64 * (idx); __builtin_amdgcn_fence(__ATOMIC_RELEASE, "agent"); asm volatile("s_waitcnt vmcnt(0)" ::: "memory"); \
            __hip_atomic_fetch_add(bw, 1u, __ATOMIC_RELAXED, __HIP_MEMORY_SCOPE_AGENT); \
            while (__hip_atomic_load(bw, __ATOMIC_RELAXED, __HIP_MEMORY_SCOPE_AGENT) < gridDim.x) __builtin_amdgcn_s_sleep(1); \
            __builtin_amdgcn_fence(__ATOMIC_ACQUIRE, "agent"); asm volatile("s_waitcnt vmcnt(0)" ::: "memory"); } \
        __syncthreads(); __builtin_amdgcn_fence(__ATOMIC_ACQUIRE, "agent"); asm volatile("s_waitcnt vmcnt(0)" ::: "memory"); } while (0)
#define SEAM(k) do { if (IN(k) && IN((k) + 1)) GRID_BARRIER(k); } while (0)
    volatile LAS unsigned* misc = (volatile LAS unsigned*)(lds + 131072);
    unsigned* ctl = (unsigned*)ws;
    if (lo == 0 && hi > 1) cg::this_grid().sync();
    if (threadIdx.x == 0) misc[3] = 0u;
    if (lo == 0) { if (threadIdx.x == 0) { const unsigned xcc = (unsigned)__builtin_amdgcn_s_getreg((3 << 11) | 20) & 0xFu;
            misc[0] = xcc; misc[1] = __hip_atomic_fetch_add(ctl + 64 * xcc, 1u, __ATOMIC_RELAXED, __HIP_MEMORY_SCOPE_AGENT); misc[2] = blockIdx.x; } }
    else { if (threadIdx.x == 0) misc[2] = blockIdx.x; }
#define VID ((int)misc[2])
    if (IN(0)) { PHASE_IDS; const int gw = blockIdx.x * 8 + wave, NGW = G * 8;
        if (G >= 256) { if (blockIdx.x < 192) p0_mod(a, mod, lds, blockIdx.x, tid, lane, wave); }
        else { for (int it = blockIdx.x; it < 192; it += G) p0_mod(a, mod, lds, it, tid, lane, wave); }
        p0_convert(a, ws, lds, gw, NGW, wave, lane);
    }
    SEAM(0);
    if (lo == 0 && hi > 1) { if (threadIdx.x == 0) { bool even = (G == 256);
            for (int j = 0; j < 16; ++j) { const unsigned cnt = __hip_atomic_load(ctl + 64 * j, __ATOMIC_RELAXED, __HIP_MEMORY_SCOPE_AGENT); if (cnt != (j < 8 ? 32u : 0u)) even = false; }
            if (even) misc[2] = misc[1] * 8u + misc[0]; else misc[3] = 1u; } }
    __syncthreads();
    if (IN(1)) { PHASE_IDS; rownorm_mod(a.x, a.norm1_g, mod, MO_SH1, MO_SC1, (bf16_t*)(ws + WS_A1), wave, G, lane, VID); }
    SEAM(1);
    if (IN(2)) {
        pg8::Gemm g{(const bf16_t*)(ws + WS_A1), (const bf16_t*)(ws + WS_WIN), nullptr, nullptr, D}; pg8::Order S; S.init(M, DIN, G, VID, 0);
        EpiIn E{(bf16_t*)(ws + WS_U), (bf16_t*)(ws + WS_GB), (bf16_t*)(ws + WS_GCV), (bf16_t*)(ws + WS_GATES), a.b_glu, a.b_gate};
        pg8::gemm_phase(lds, g, S, E);
    }
    SEAM(2);
    if (IN(3)) { PHASE_IDS; p3_conv(a, ws, lds, tid, lane, wave, VID); }
    SEAM(3);
    if (IN(4)) {
        { pg8::Gemm g{(const bf16_t*)(ws + WS_UA), (const bf16_t*)(ws + WS_WA), nullptr, nullptr, DC}; pg8::Order S; S.init(M, D, G, VID, 0);
          EpiDual E{(bf16_t*)(ws + WS_T), (bf16_t*)(ws + WS_MIX), (const bf16_t*)(ws + WS_GATES), a.conf_b_out, 0};
          pg8::gemm_phase(lds, g, S, E); }
        if (lo == 0 && hi >= 5) GRID_BARRIER(9); else { asm volatile("s_waitcnt vmcnt(0)" ::: "memory"); __syncthreads(); __builtin_amdgcn_fence(__ATOMIC_ACQUIRE, "agent"); asm volatile("s_waitcnt vmcnt(0)" ::: "memory"); }
        if (!PROBE_NOGATE) { pg8::Gemm g{(const bf16_t*)(ws + WS_VB), (const bf16_t*)(ws + WS_WB), nullptr, nullptr, DC}; pg8::Order S; S.init(M, D, G, VID, 0);
          EpiDual E{(bf16_t*)(ws + WS_T), (bf16_t*)(ws + WS_MIX), (const bf16_t*)(ws + WS_GATES), a.conf_b_out, 1};
          pg8::gemm_phase(lds, g, S, E); }
    }
    SEAM(4);
    if (IN(5)) {
        pg8::Gemm g{(const bf16_t*)(ws + WS_MIX), (const bf16_t*)(ws + WS_WO), nullptr, nullptr, D}; pg8::Order S; S.init(M, D, G, VID, 0);
        #if STOP_AFTER == 5
        EpiRes E{(const float*)(ws + WS_ACT), a.out, mod + MO_GT1, 8.0f};
#else
        EpiRes E{a.x, (float*)(ws + WS_X1), mod + MO_GT1, 1.0f};
#endif
        pg8::gemm_phase(lds, g, S, E);
    }
    SEAM(5);
    if (IN(6)) { PHASE_IDS; rownorm_mod((const float*)(ws + WS_X1), a.norm2_g, mod, MO_SH2, MO_SC2, (bf16_t*)(ws + WS_A1), wave, G, lane, VID); }
    SEAM(6);
    if (IN(7)) {
        pg8::Gemm g{(const bf16_t*)(ws + WS_A1), (const bf16_t*)(ws + WS_WGU), nullptr, nullptr, D}; pg8::Order S; S.init(M, NGU, G, VID, 0);
        EpiGU E{(bf16_t*)(ws + WS_ACT)};
        pg8::gemm_phase(lds, g, S, E);
    }
    SEAM(7);
    if (IN(8)) {
        pg8::Gemm g{(const bf16_t*)(ws + WS_ACT), (const bf16_t*)(ws + WS_WDN), nullptr, nullptr, DFF}; pg8::Order S; S.init(M, D, G, VID, 0);
        EpiRes E{(const float*)(ws + WS_X1), (float*)(ws + WS_X1), mod + MO_GT2, 1.0f};
        pg8::gemm_phase(lds, g, S, E);
    }
#ifdef DUMP_IN_KERNEL
    if (hi == 8) { asm volatile("s_waitcnt vmcnt(0) lgkmcnt(0)" ::: "memory"); cg::this_grid().sync(); __builtin_amdgcn_fence(__ATOMIC_ACQUIRE, "agent"); asm volatile("s_waitcnt vmcnt(0)" ::: "memory");
        PHASE_IDS; const bf16_t* ACTp = (const bf16_t*)(ws + WS_ACT);
        for (int it = 0; it < own_cnt(G); ++it) { const int m = own_row(it, wave, G, VID); if (m >= M) break;
            for (int j = 0; j < 16; ++j) a.out[(size_t)m * D + j * 64 + lane] = bf2f(ACTp[(size_t)m * DFF + j * 64 + lane]); } }
    if (hi == 7) { asm volatile("s_waitcnt vmcnt(0) lgkmcnt(0)" ::: "memory"); cg::this_grid().sync(); __builtin_amdgcn_fence(__ATOMIC_ACQUIRE, "agent"); asm volatile("s_waitcnt vmcnt(0)" ::: "memory");
        PHASE_IDS; const bf16_t* Ap = (const bf16_t*)(ws + WS_A1);
        for (int it = 0; it < own_cnt(G); ++it) { const int m = own_row(it, wave, G, VID); if (m >= M) break;
            for (int j = 0; j < 16; ++j) a.out[(size_t)m * D + j * 64 + lane] = bf2f(Ap[(size_t)m * D + j * 64 + lane]); } }
#endif
    SEAM(8);
    if (IN(9)) { PHASE_IDS; final_norm((const float*)(ws + WS_X1), a.out, a.final_g, wave, G, lane, VID); }
    if (hi == 10 && threadIdx.x == 0 && misc[3] != 0u) { asm volatile("s_waitcnt vmcnt(0)" ::: "memory"); a.out[(size_t)blockIdx.x * 4096] = __builtin_nanf(""); }
#ifdef XCC_PROBE
    { const unsigned xcc = (unsigned)__builtin_amdgcn_s_getreg((3 << 11) | 20) & 0xFu;
      if (xcc != (blockIdx.x & 7u) && threadIdx.x == 0) { asm volatile("s_waitcnt vmcnt(0)" ::: "memory"); a.out[(size_t)blockIdx.x * 4096] = __builtin_nanf(""); } }
#endif
#undef IN
#undef SEAM
}
__global__ void dump_bf16(const bf16_t* src, float* out, int n) { for (int i = blockIdx.x * blockDim.x + threadIdx.x; i < n; i += gridDim.x * blockDim.x) out[i] = DUMP_SCALE * bf2f(src[i]); }
__global__ void dump_f32(const float* src, int nsrc, float* out, int n) { for (int i = blockIdx.x * blockDim.x + threadIdx.x; i < n; i += gridDim.x * blockDim.x) out[i] = DUMP_SCALE * src[i % nsrc]; }
__global__ void __launch_bounds__(512, 2) mega(Args a) { mega_body<0, STOP_AFTER + 1>(a); }
#if MODE != 2
template <int PH> __global__ void __launch_bounds__(512, 2) mega_ph(Args a) { mega_body<PH, PH + 1>(a); }
template <int PH> static void launch_ph(const Args& a, int grid, hipStream_t stream) {
    static bool once = false; if (!once) { once = true; (void)hipFuncSetAttribute((const void*)mega_ph<PH>, hipFuncAttributeMaxDynamicSharedMemorySize, LDS_BYTES); }
    mega_ph<PH><<<dim3(grid), dim3(512), LDS_BYTES, stream>>>(a);
}
#endif

struct NaiveEpi { int kind; const Args* dummy; const float *p0, *p1, *p2; bf16_t *o0, *o1, *o2, *o3; const bf16_t* g; float* fo; };
__device__ __forceinline__ int ne_c0(int kind, int lc) { if (kind == 2) { if (lc < 512) return lc; if (lc < 1024) return 1024 + (lc - 512); if (lc < 1536) return 1536 + (lc - 1024); return 2560 + (lc - 1536); } return lc; }
__device__ __forceinline__ int ne_c1(int kind, int lc) { if (kind == 2) { if (lc < 512) return 512 + lc; if (lc < 1024) return 1024 + (lc - 512); if (lc < 1536) return 2048 + (lc - 1024); return 2560 + (lc - 1536); } if (kind == 7) return DFF + lc; return lc; }
template <bool DUAL>
__global__ void __launch_bounds__(256) naive_gemm(const bf16_t* A0, const float* W0, int ldw0, const bf16_t* A1, const float* W1, int ldw1, int K, NaiveEpi e) {
    const int lc = blockIdx.x * 256 + threadIdx.x, r0 = blockIdx.y * 16;
    const int c0 = ne_c0(e.kind, lc), c1 = ne_c1(e.kind, lc);
    float a0[16], a1[16];
#pragma unroll
    for (int i = 0; i < 16; ++i) { a0[i] = 0.f; a1[i] = 0.f; }
    for (int k = 0; k < K; k += 2) {
        const float w00 = W0[(size_t)k * ldw0 + c0], w01 = W0[(size_t)(k + 1) * ldw0 + c0];
        float w10 = 0.f, w11 = 0.f; if (DUAL) { w10 = W1[(size_t)k * ldw1 + c1]; w11 = W1[(size_t)(k + 1) * ldw1 + c1]; }
#pragma unroll
        for (int i = 0; i < 16; ++i) { const unsigned av = *(const volatile unsigned*)(A0 + (size_t)(r0 + i) * K + k); a0[i] += bf_lo(av) * w00 + bf_hi(av) * w01;
            if (DUAL) { const unsigned bv = *(const volatile unsigned*)(A1 + (size_t)(r0 + i) * K + k); a1[i] += bf_lo(bv) * w10 + bf_hi(bv) * w11; } }
    }
#pragma unroll
    for (int i = 0; i < 16; ++i) { const size_t row = (size_t)(r0 + i); const int b = (r0 + i) >> 11; const float v0 = a0[i], v1 = a1[i];
        if (e.kind == 2) {
            if (lc < 512) e.o0[row * DC + lc] = f2bf((v0 + e.p0[lc]) * sigm(v1 + e.p0[512 + lc]));
            else if (lc < 1024) e.o1[row * DC + (lc - 512)] = f2bf(v0);
            else if (lc < 1536) e.o2[row * DC + (lc - 1024)] = f2bf(v0 * v1);
            else e.o3[row * 2048 + (lc - 1536)] = f2bf(sigm(v0 + e.p1[lc - 1536]));
        } else if (e.kind == 4) { const float ga = bf2f(e.g[row * 2048 + lc]), gb = bf2f(e.g[row * 2048 + 1024 + lc]); e.o0[row * D + lc] = f2bf(ga * (v0 + e.p0[lc]) + gb * v1);
        } else if (e.kind == 5 || e.kind == 8) { e.fo[row * D + lc] = e.p2[row * D + lc] + e.p0[(size_t)b * NMOD + lc] * v0;
        } else if (e.kind == 7) { e.o0[row * DFF + lc] = f2bf(v0 * sigm(v0) * v1); }
    }
}

extern "C" void kernel_launch(void* const* d_in, const int* in_sizes, int n_in, void* d_out, int out_size, void* d_ws, size_t ws_size, hipStream_t stream) {
    static int grid = 0;
    if (grid == 0) {
        if (n_in != 21 || out_size != M * D || ws_size < WS_END) { fprintf(stderr, "kernel_launch: unexpected shapes (n_in %d out %d ws %zu)\n", n_in, out_size, ws_size); grid = -1; return; }
        int dev = 0, cus = 0, per_cu = 0;
        hipGetDevice(&dev); hipDeviceGetAttribute(&cus, hipDeviceAttributeMultiprocessorCount, dev);
        if (hipFuncSetAttribute((const void*)mega, hipFuncAttributeMaxDynamicSharedMemorySize, LDS_BYTES) != hipSuccess) { fprintf(stderr, "kernel_launch: hipFuncSetAttribute failed\n"); grid = -1; return; }
        if (hipOccupancyMaxActiveBlocksPerMultiprocessor(&per_cu, (const void*)mega, 512, LDS_BYTES) != hipSuccess || per_cu < 1) { fprintf(stderr, "kernel_launch: occupancy query gave %d\n", per_cu); per_cu = 1; }
        (void)hipGetLastError();
        grid = cus * per_cu;
    }
    if (grid < 0) return;
    Args a{};
    const float** ap = (const float**)&a;
    for (int i = 0; i < 21; ++i) ap[i] = (const float*)d_in[i];
    a.out = (float*)d_out; a.ws = (unsigned char*)d_ws;
    unsigned char* ws = (unsigned char*)d_ws; float* mod = (float*)(ws + WS_MOD); (void)mod;
    (void)hipMemsetAsync(d_ws, 0, 8192, stream);
#ifdef EXP_MEMSET
    (void)hipMemsetAsync((char*)d_ws + 8192, 0, 256 * MiB - 8192, stream); (void)hipMemsetAsync(d_out, 0, (size_t)M * D * 4, stream);
#endif
#if MODE == 2
    a.ph_lo = 0; a.ph_hi = 10;
    { void* args[] = {&a}; hipError_t e = hipLaunchCooperativeKernel((const void*)mega, dim3(grid), dim3(512), args, LDS_BYTES, stream);
      if (e != hipSuccess) fprintf(stderr, "cooperative launch failed: %s (grid %d)\n", hipGetErrorString(e), grid); }
#else
    const unsigned naive_mask = (MODE == 0) ? 0x1B4u : (unsigned)(NAIVE_MASK);
    for (int ph = 0; ph <= STOP_AFTER; ++ph) {
        if (naive_mask & (1u << ph)) {
            NaiveEpi e{}; e.kind = ph;
            if (ph == 2) { e.p0 = a.b_glu; e.p1 = a.b_gate; e.o0 = (bf16_t*)(ws + WS_U); e.o1 = (bf16_t*)(ws + WS_GB); e.o2 = (bf16_t*)(ws + WS_GCV); e.o3 = (bf16_t*)(ws + WS_GATES);
                naive_gemm<true><<<dim3(3584 / 256, M / 16), 256, 0, stream>>>((const bf16_t*)(ws + WS_A1), a.w_in, DIN, (const bf16_t*)(ws + WS_A1), a.w_in, DIN, D, e); }
            else if (ph == 4) { e.p0 = a.conf_b_out; e.g = (const bf16_t*)(ws + WS_GATES); e.o0 = (bf16_t*)(ws + WS_MIX);
                naive_gemm<true><<<dim3(D / 256, M / 16), 256, 0, stream>>>((const bf16_t*)(ws + WS_UA), a.conf_w_out, D, (const bf16_t*)(ws + WS_VB), a.sc_w_out, D, DC, e); }
            else if (ph == 5) { e.p0 = mod + MO_GT1; e.p2 = a.x; e.fo = (float*)(ws + WS_X1);
                naive_gemm<false><<<dim3(D / 256, M / 16), 256, 0, stream>>>((const bf16_t*)(ws + WS_MIX), a.w_o, D, nullptr, nullptr, 0, D, e); }
            else if (ph == 7) { e.o0 = (bf16_t*)(ws + WS_ACT);
                naive_gemm<true><<<dim3(DFF / 256, M / 16), 256, 0, stream>>>((const bf16_t*)(ws + WS_A1), a.w_gu, NGU, (const bf16_t*)(ws + WS_A1), a.w_gu, NGU, D, e); }
            else if (ph == 8) { e.p0 = mod + MO_GT2; e.p2 = (const float*)(ws + WS_X1); e.fo = (float*)(ws + WS_X1);
                naive_gemm<false><<<dim3(D / 256, M / 16), 256, 0, stream>>>((const bf16_t*)(ws + WS_ACT), a.w_down, D, nullptr, nullptr, 0, DFF, e); }
        } else {
            switch (ph) { case 0: launch_ph<0>(a, grid, stream); break; case 1: launch_ph<1>(a, grid, stream); break; case 2: launch_ph<2>(a, grid, stream); break; case 3: launch_ph<3>(a, grid, stream); break;
                case 4: launch_ph<4>(a, grid, stream); break; case 5: launch_ph<5>(a, grid, stream); break; case 6: launch_ph<6>(a, grid, stream); break; case 7: launch_ph<7>(a, grid, stream); break;
                case 8: launch_ph<8>(a, grid, stream); break; default: launch_ph<9>(a, grid, stream); break; }
        }
    }
#endif
    if (STOP_AFTER == 0) dump_f32<<<1024, 256, 0, stream>>>(mod, NB * NMOD, a.out, M * D);
    else if (STOP_AFTER == 1) dump_bf16<<<1024, 256, 0, stream>>>((const bf16_t*)(ws + WS_A1), a.out, M * D);
    else if (STOP_AFTER == 2) dump_bf16<<<1024, 256, 0, stream>>>((const bf16_t*)(ws + WS_GATES), a.out, M * D);
    else if (STOP_AFTER == 3) dump_bf16<<<1024, 256, 0, stream>>>((const bf16_t*)(ws + WS_UA), a.out, M * D);
    else if (STOP_AFTER == 4) dump_bf16<<<1024, 256, 0, stream>>>((const bf16_t*)(ws + (PROBE_NOGATE ? WS_T : WS_MIX)), a.out, M * D);
    else if (STOP_AFTER == 6 && MODE != 2) dump_bf16<<<1024, 256, 0, stream>>>((const bf16_t*)(ws + WS_A1), a.out, M * D);
    else if (STOP_AFTER == 7 && MODE != 2) dump_bf16<<<1024, 256, 0, stream>>>((const bf16_t*)(ws + WS_ACT), a.out, M * D);
}
```

```cpp
#include <hip/hip_runtime.h>
#include <hip/hip_cooperative_groups.h>
#include <cstdio>
#include <cstdint>
namespace cg = cooperative_groups;

#ifndef PROBE_NOGATE
#define PROBE_NOGATE 0
#endif
#ifndef DUMP_SCALE
#define DUMP_SCALE 1.0f
#endif
#ifndef STOP_AFTER
#define STOP_AFTER 9
#endif
#ifndef MODE
#define MODE 2
#endif
#ifndef NAIVE_MASK
#define NAIVE_MASK 0
#endif

#define LAS __attribute__((address_space(3)))
typedef unsigned short bf16_t;
typedef short bf16x8 __attribute__((ext_vector_type(8)));
typedef float f32x4 __attribute__((ext_vector_type(4)));
typedef float f32x2 __attribute__((ext_vector_type(2)));
typedef unsigned u32x4 __attribute__((ext_vector_type(4)));
typedef unsigned u32x2 __attribute__((ext_vector_type(2)));

constexpr int NB = 8, SEQ = 2048, D = 1024, M = NB * SEQ, DC = 512, DIN = 4608, DFF = 2816, NGU = 2 * DFF, NMOD = 6 * D;
constexpr int CONF_K = 31;
constexpr float RMS_EPS = 1e-6f, LN_EPS = 1e-5f;
constexpr int MO_SH1 = 0, MO_SC1 = D, MO_GT1 = 2 * D, MO_SH2 = 3 * D, MO_SC2 = 4 * D, MO_GT2 = 5 * D;

constexpr size_t MiB = 1u << 20;
constexpr size_t WS_MOD = 1 * MiB;
constexpr size_t WS_WIN = 8 * MiB;
constexpr size_t WS_WA = 17 * MiB;
constexpr size_t WS_WB = 18 * MiB;
constexpr size_t WS_WO = 19 * MiB;
constexpr size_t WS_WGU = 21 * MiB;
constexpr size_t WS_WDN = 32 * MiB;
constexpr size_t WS_A1 = 40 * MiB;
constexpr size_t WS_UA = 40 * MiB, WS_VB = 56 * MiB;
constexpr size_t WS_U = 72 * MiB, WS_GCV = 88 * MiB, WS_GB = 104 * MiB;
constexpr size_t WS_GATES = 120 * MiB;
constexpr size_t WS_T = 72 * MiB;
constexpr size_t WS_ACT = 72 * MiB;
constexpr size_t WS_X1 = 160 * MiB;
constexpr size_t WS_MIX = 224 * MiB;
constexpr size_t WS_END = 256 * MiB;

constexpr int LDS_BYTES = 131072 + 2048;

struct Args {
    const float *x, *c, *w_ada, *b_ada, *norm1_g, *w_in, *b_glu, *conf_dw_w, *conf_dw_b, *conf_ln_g, *conf_ln_b, *conf_w_out, *conf_b_out,
        *sc_dw_w, *sc_w_out, *b_gate, *w_o, *norm2_g, *w_gu, *w_down, *final_g;
    float* out; unsigned char* ws; int ph_lo, ph_hi;
};

__device__ __forceinline__ float bf_lo(unsigned v) { return __uint_as_float(v << 16); }
__device__ __forceinline__ float bf_hi(unsigned v) { return __uint_as_float(v & 0xffff0000u); }
__device__ __forceinline__ float bf2f(bf16_t v) { return __uint_as_float(((unsigned)v) << 16); }
typedef __bf16 bf16x2_t __attribute__((ext_vector_type(2)));
__device__ __forceinline__ unsigned cvt_pk_bf16(float lo, float hi) { const f32x2 v = {lo, hi}; const bf16x2_t b = __builtin_convertvector(v, bf16x2_t); return __builtin_bit_cast(unsigned, b); }
__device__ __forceinline__ bf16_t f2bf(float f) { return (bf16_t)(cvt_pk_bf16(f, 0.f) & 0xffffu); }
__device__ __forceinline__ u32x4 pack8(const f32x4 a, const f32x4 b) { u32x4 w; w.x = cvt_pk_bf16(a[0], a[1]); w.y = cvt_pk_bf16(a[2], a[3]); w.z = cvt_pk_bf16(b[0], b[1]); w.w = cvt_pk_bf16(b[2], b[3]); return w; }
__device__ __forceinline__ void unpack8(const u32x4 w, f32x4& a, f32x4& b) { a[0] = bf_lo(w.x); a[1] = bf_hi(w.x); a[2] = bf_lo(w.y); a[3] = bf_hi(w.y); b[0] = bf_lo(w.z); b[1] = bf_hi(w.z); b[2] = bf_lo(w.w); b[3] = bf_hi(w.w); }
__device__ __forceinline__ float sigm(float x) { return __builtin_amdgcn_rcpf(1.0f + __builtin_amdgcn_exp2f(-1.4426950408889634f * x)); }
__device__ __forceinline__ int opaque_tid() { int t = threadIdx.x; asm volatile("" : "+v"(t)); return t; }
__device__ __forceinline__ float wave_sum(float v) {
#pragma unroll
    for (int o = 1; o < 64; o <<= 1) v += __shfl_xor(v, o);
    return v;
}
__device__ __forceinline__ int map_in(int r) {
    const int t = r >> 8, j = r & 255, h = j >> 7, jj = j & 127;
    if (t < 4) return h * 512 + 128 * t + jj;
    if (t < 6) return 1024 + 256 * (t - 4) + j;
    if (t < 10) return (h ? 2048 : 1536) + 128 * (t - 6) + jj;
    return 2560 + 256 * (t - 10) + j;
}
__device__ __forceinline__ int map_gu(int r) { const int t = r >> 8, j = r & 255, h = j >> 7, jj = j & 127; return h * DFF + 128 * t + jj; }

namespace pg8 {
constexpr int BM = 256, BK = 64, HALF = 128, HTB = HALF * BK * 2, STAGE_BYTES = 8 * HTB, NXCD = 8, WGM = 8;
__device__ __forceinline__ int lds_byte(int r, int c) { const int st = (r >> 4) * 2 + (c >> 5), rr = r & 15, cc = c & 31, ob = rr * 64 + cc * 2; return st * 1024 + (ob ^ (((ob >> 9) & 1) << 5)); }
__device__ __forceinline__ void stage_rc(int b, int& R, int& C) { const int st = b / 1024, sb = b % 1024, swz = sb ^ (((sb >> 9) & 1) << 5); R = (st >> 1) * 16 + swz / 64; C = (st & 1) * 32 + (swz % 64) / 2; }
__device__ __forceinline__ int perm32(int rho) { const int n = rho >> 4, i = rho & 15; return 8 * (i >> 2) + 4 * n + (i & 3); }

struct Unit { int pm, pn, sel; };
struct Gemm { const bf16_t *A0, *B0, *A1, *B1; int K; };

struct Order {
    int nM, nN, nwg, G, c, dual;
    __device__ void init(int M_, int N_, int G_, int c_, int dual_) { nM = M_ / BM; nN = N_ / BM; nwg = nM * nN; G = G_; c = c_; dual = dual_; }
    __device__ bool next(int i, Unit& u) const {
        const int ii = dual ? (i >> 1) : i;
        const long L = (long)ii * G + c; if (L >= nwg) return false;
        int wgid = (int)L; { const int q = nwg / NXCD, r = nwg % NXCD, xcd = wgid % NXCD, off = wgid / NXCD; wgid = (xcd < r ? xcd * (q + 1) : r * (q + 1) + (xcd - r) * q) + off; }
        const int nig = WGM * nN, gid = wgid / nig, fm = gid * WGM, gsz = (nM - fm) < WGM ? (nM - fm) : WGM;
        u.pm = fm + ((wgid % nig) % gsz); u.pn = (wgid % nig) / gsz; u.sel = dual ? (i & 1) : 0; return true;
    }
};

template <class Epi>
__device__ __forceinline__ void gemm_phase(LAS unsigned char* lds, const Gemm g, const Order& S, const Epi& E) {
    const int tid = opaque_tid(), wid = __builtin_amdgcn_readfirstlane(tid >> 6), lane = tid & 63, wr = wid >> 2, wc = wid & 3, fr = lane & 15, fq = lane >> 4;
    const int K = g.K, nt = K / BK;
    unsigned voffA[2], voffB[2];
#pragma unroll
    for (int i = 0; i < 2; ++i) { int R, C; stage_rc(tid * 16 + i * 8192, R, C); const int Rb = (R & ~31) + perm32(R & 31);
        voffA[i] = (unsigned)(R * K + C) * 2u; voffB[i] = (unsigned)(Rb * K + C) * 2u; }
    const size_t kstep = (size_t)(BK * 2);
    const size_t hstep = (size_t)HALF * K * 2;
    const size_t tstep = 2 * hstep;
    const unsigned ldsw = (unsigned)wid * 1024u;
    const int aoff = lds_byte(wr * 64 + fr, fq * 8), boff = lds_byte(wc * 32 + fr, fq * 8);
#define PG8_SA(b, h) (((b) * 2 + (h)) * HTB)
#define PG8_SB(b, h) ((4 + (b) * 2 + (h)) * HTB)
#define PG8_STAGE(bufoff, gbase, voff) do { _Pragma("unroll") for (int _i = 0; _i < 2; ++_i) \
        __builtin_amdgcn_global_load_lds((const unsigned*)((const char*)(gbase) + (voff)[_i]), (LAS unsigned*)(lds + (bufoff) + ldsw + _i * 8192), 16, 0, 0); } while (0)
#define PG8_LDA(dst, b, h) do { _Pragma("unroll") for (int m = 0; m < 4; ++m) _Pragma("unroll") for (int k = 0; k < 2; ++k) dst[m][k] = *(const LAS bf16x8*)(lds + PG8_SA(b, h) + aoff + m * 2048 + k * 1024); } while (0)
#define PG8_LDB(dst, b, h) do { _Pragma("unroll") for (int n = 0; n < 2; ++n) _Pragma("unroll") for (int k = 0; k < 2; ++k) dst[n][k] = *(const LAS bf16x8*)(lds + PG8_SB(b, h) + boff + n * 2048 + k * 1024); } while (0)
#define PG8_MMA(ai, bj, At, Bt) do { __builtin_amdgcn_s_setprio(1); _Pragma("unroll") for (int m = 0; m < 4; ++m) _Pragma("unroll") for (int n = 0; n < 2; ++n) _Pragma("unroll") for (int k = 0; k < 2; ++k) \
        acc[ai][bj][m][n] = __builtin_amdgcn_mfma_f32_16x16x32_bf16(Bt[n][k], At[m][k], acc[ai][bj][m][n], 0, 0, 0); __builtin_amdgcn_s_setprio(0); } while (0)
#define PG8_WAIT_V(n) asm volatile("s_waitcnt vmcnt(" #n ")" ::: "memory")
#define PG8_WAIT_L(n) asm volatile("s_waitcnt lgkmcnt(" #n ")" ::: "memory")
#define PG8_BAR __builtin_amdgcn_s_barrier()
#define PG8_SCHED __builtin_amdgcn_sched_barrier(0)
    Unit cur, nxt; int ui = 0;
    if (!S.next(0, cur)) return;
    f32x4 acc[2][2][4][2];
#pragma unroll
    for (int a = 0; a < 2; ++a)
#pragma unroll
        for (int b = 0; b < 2; ++b)
#pragma unroll
            for (int m = 0; m < 4; ++m)
#pragma unroll
                for (int n = 0; n < 2; ++n) acc[a][b][m][n] = (f32x4){0.f, 0.f, 0.f, 0.f};
    bf16x8 At[4][2], B0[2][2], B1[2][2];
    const char* cA = (const char*)(cur.sel ? g.A1 : g.A0) + (size_t)cur.pm * tstep; const char* cB = (const char*)(cur.sel ? g.B1 : g.B0) + (size_t)cur.pn * tstep;
    PG8_STAGE(PG8_SB(0, 0), cB, voffB); PG8_STAGE(PG8_SB(0, 1), cB + hstep, voffB); PG8_STAGE(PG8_SA(0, 0), cA, voffA); PG8_STAGE(PG8_SA(0, 1), cA + hstep, voffA);
    if (wr == 1) PG8_BAR;
    PG8_WAIT_V(2); PG8_BAR;
    PG8_STAGE(PG8_SB(1, 0), cB + kstep, voffB); PG8_STAGE(PG8_SA(1, 0), cA + kstep, voffA); PG8_STAGE(PG8_SB(1, 1), cB + hstep + kstep, voffB);
    PG8_WAIT_V(6); PG8_BAR;
    for (;;) {
        const bool has_next = S.next(ui + 1, nxt);
        const char* nA = has_next ? (const char*)(nxt.sel ? g.A1 : g.A0) + (size_t)nxt.pm * tstep : cA; const char* nB = has_next ? (const char*)(nxt.sel ? g.B1 : g.B0) + (size_t)nxt.pn * tstep : cB;
        for (int t = 0; t < nt; t += 2) {
            const bool last = (t == nt - 2);
            const char* a1 = cA + (size_t)(t + 1) * kstep;
            const char* a2 = last ? nA : cA + (size_t)(t + 2) * kstep; const char* b2 = last ? nB : cB + (size_t)(t + 2) * kstep;
            const char* a3 = a2 + kstep; const char* b3 = b2 + kstep;
            PG8_LDB(B0, 0, 0); PG8_LDB(B1, 0, 1); PG8_SCHED; PG8_LDA(At, 0, 0); PG8_STAGE(PG8_SA(1, 1), a1 + hstep, voffA);
            PG8_WAIT_V(8); PG8_WAIT_L(0); PG8_BAR; PG8_MMA(0, 0, At, B0); PG8_MMA(0, 1, At, B1); PG8_BAR; PG8_SCHED;
            PG8_LDA(At, 0, 1); PG8_STAGE(PG8_SB(0, 0), b2, voffB); PG8_STAGE(PG8_SB(0, 1), b2 + hstep, voffB); PG8_STAGE(PG8_SA(0, 0), a2, voffA);
            PG8_WAIT_V(8); PG8_WAIT_L(0); PG8_BAR; PG8_MMA(1, 0, At, B0); PG8_MMA(1, 1, At, B1); PG8_BAR; PG8_SCHED;
            PG8_LDB(B0, 1, 0); PG8_LDB(B1, 1, 1); PG8_SCHED; PG8_LDA(At, 1, 0); PG8_STAGE(PG8_SA(0, 1), a2 + hstep, voffA);
            PG8_WAIT_V(8); PG8_WAIT_L(0); PG8_BAR; PG8_MMA(0, 0, At, B0); PG8_MMA(0, 1, At, B1); PG8_BAR; PG8_SCHED;
            PG8_LDA(At, 1, 1); PG8_STAGE(PG8_SB(1, 0), b3, voffB); PG8_STAGE(PG8_SB(1, 1), b3 + hstep, voffB); PG8_STAGE(PG8_SA(1, 0), a3, voffA);
            PG8_WAIT_V(8); PG8_WAIT_L(0); PG8_BAR; PG8_MMA(1, 0, At, B0); PG8_MMA(1, 1, At, B1); PG8_BAR; PG8_SCHED;
        }
        if (wr == 0) PG8_BAR;
        E(acc, cur, wr, wc, fr, fq);
        if (!has_next) break;
#pragma unroll
        for (int a = 0; a < 2; ++a)
#pragma unroll
            for (int b = 0; b < 2; ++b)
#pragma unroll
                for (int m = 0; m < 4; ++m)
#pragma unroll
                    for (int n = 0; n < 2; ++n) acc[a][b][m][n] = (f32x4){0.f, 0.f, 0.f, 0.f};
        cur = nxt; cA = nA; cB = nB; ++ui;
        if (wr == 1) PG8_BAR;
    }
    PG8_WAIT_V(0);
    PG8_BAR;
#undef PG8_SA
#undef PG8_SB
#undef PG8_STAGE
#undef PG8_LDA
#undef PG8_LDB
#undef PG8_MMA
#undef PG8_WAIT_V
#undef PG8_WAIT_L
#undef PG8_BAR
#undef PG8_SCHED
}
}

typedef const f32x4 (&AccRef)[2][2][4][2];
struct EpiIn {
    bf16_t *U, *GB, *GCV, *GATES; const float *b_glu, *b_gate;
    __device__ __forceinline__ void operator()(AccRef acc, const pg8::Unit& u, int wr, int wc, int fr, int fq) const {
        const int row0 = u.pm * 256 + wr * 64 + fr, t = u.pn, cw = wc * 32 + fq * 8;
        if (t < 4) {
            const int cA = 128 * t + cw; f32x4 ba[2], bb[2];
#pragma unroll
            for (int n = 0; n < 2; ++n) { ba[n] = *(const f32x4*)(b_glu + cA + 4 * n); bb[n] = *(const f32x4*)(b_glu + 512 + cA + 4 * n); }
#pragma unroll
            for (int ai = 0; ai < 2; ++ai)
#pragma unroll
                for (int m = 0; m < 4; ++m) { f32x4 r[2];
#pragma unroll
                    for (int n = 0; n < 2; ++n) { const f32x4 a = acc[ai][0][m][n] + ba[n], b = acc[ai][1][m][n] + bb[n];
#pragma unroll
                        for (int j = 0; j < 4; ++j) r[n][j] = a[j] * sigm(b[j]); }
                    *(u32x4*)(U + (size_t)(row0 + ai * 128 + m * 16) * DC + cA) = pack8(r[0], r[1]); }
        } else if (t < 6) {
            const int c0 = 256 * (t - 4) + cw;
#pragma unroll
            for (int ai = 0; ai < 2; ++ai)
#pragma unroll
                for (int m = 0; m < 4; ++m)
#pragma unroll
                    for (int bj = 0; bj < 2; ++bj) *(u32x4*)(GB + (size_t)(row0 + ai * 128 + m * 16) * DC + c0 + 128 * bj) = pack8(acc[ai][bj][m][0], acc[ai][bj][m][1]);
        } else if (t < 10) {
            const int cA = 128 * (t - 6) + cw;
#pragma unroll
            for (int ai = 0; ai < 2; ++ai)
#pragma unroll
                for (int m = 0; m < 4; ++m)
                    *(u32x4*)(GCV + (size_t)(row0 + ai * 128 + m * 16) * DC + cA) = pack8(acc[ai][0][m][0] * acc[ai][1][m][0], acc[ai][0][m][1] * acc[ai][1][m][1]);
        } else {
            const int c0 = 256 * (t - 10) + cw; f32x4 bv[2][2];
#pragma unroll
            for (int bj = 0; bj < 2; ++bj)
#pragma unroll
                for (int n = 0; n < 2; ++n) bv[bj][n] = *(const f32x4*)(b_gate + c0 + 128 * bj + 4 * n);
#pragma unroll
            for (int ai = 0; ai < 2; ++ai)
#pragma unroll
                for (int m = 0; m < 4; ++m)
#pragma unroll
                    for (int bj = 0; bj < 2; ++bj) { f32x4 r[2];
#pragma unroll
                        for (int n = 0; n < 2; ++n) { const f32x4 a = acc[ai][bj][m][n] + bv[bj][n];
#pragma unroll
                            for (int j = 0; j < 4; ++j) r[n][j] = sigm(a[j]); }
                        *(u32x4*)(GATES + (size_t)(row0 + ai * 128 + m * 16) * 2048 + c0 + 128 * bj) = pack8(r[0], r[1]); }
        }
    }
};
struct EpiDual {
    bf16_t *T, *MIX; const bf16_t* GATES; const float* b_out; int mode;
    __device__ __forceinline__ void operator()(AccRef acc, const pg8::Unit& u, int wr, int wc, int fr, int fq) const {
        const int row0 = u.pm * 256 + wr * 64 + fr, c0 = 256 * u.pn + wc * 32 + fq * 8;
        if ((mode < 0 ? u.sel : mode) == 0) {
            f32x4 bv[2][2];
#pragma unroll
            for (int bj = 0; bj < 2; ++bj)
#pragma unroll
                for (int n = 0; n < 2; ++n) bv[bj][n] = *(const f32x4*)(b_out + c0 + 128 * bj + 4 * n);
#pragma unroll
            for (int ai = 0; ai < 2; ++ai)
#pragma unroll
                for (int m = 0; m < 4; ++m) { const size_t row = (size_t)(row0 + ai * 128 + m * 16);
#pragma unroll
                    for (int bj = 0; bj < 2; ++bj) { f32x4 g0, g1; unpack8(*(const u32x4*)(GATES + row * 2048 + c0 + 128 * bj), g0, g1);
                        if (PROBE_NOGATE) { g0 = (f32x4){1.f, 1.f, 1.f, 1.f}; g1 = g0; }
                        *(u32x4*)(T + row * D + c0 + 128 * bj) = pack8(g0 * (acc[ai][bj][m][0] + bv[bj][0]), g1 * (acc[ai][bj][m][1] + bv[bj][1])); }
                    asm volatile("" ::: "memory"); }
        } else {
#pragma unroll
            for (int ai = 0; ai < 2; ++ai)
#pragma unroll
                for (int m = 0; m < 4; ++m) { const size_t row = (size_t)(row0 + ai * 128 + m * 16);
#pragma unroll
                    for (int bj = 0; bj < 2; ++bj) { f32x4 g0, g1, t0, t1; unpack8(*(const u32x4*)(GATES + row * 2048 + 1024 + c0 + 128 * bj), g0, g1);
                        unpack8(*(const u32x4*)(T + row * D + c0 + 128 * bj), t0, t1);
                        *(u32x4*)(MIX + row * D + c0 + 128 * bj) = pack8(t0 + g0 * acc[ai][bj][m][0], t1 + g1 * acc[ai][bj][m][1]); }
                    asm volatile("" ::: "memory"); }
        }
    }
};
struct EpiRes {
    const float* xin; float* xout; const float* gt; float scale;
    __device__ __forceinline__ void operator()(AccRef acc, const pg8::Unit& u, int wr, int wc, int fr, int fq) const {
        const int row0 = u.pm * 256 + wr * 64 + fr, c0 = 256 * u.pn + wc * 32 + fq * 8, b = u.pm >> 3; f32x4 gv[2][2];
#pragma unroll
        for (int bj = 0; bj < 2; ++bj)
#pragma unroll
            for (int n = 0; n < 2; ++n) gv[bj][n] = *(const f32x4*)(gt + (size_t)b * NMOD + c0 + 128 * bj + 4 * n);
        f32x4 cur[2][2], nxt[2][2];
        { const size_t off = (size_t)row0 * D + c0;
#pragma unroll
          for (int bj = 0; bj < 2; ++bj)
#pragma unroll
              for (int n = 0; n < 2; ++n) cur[bj][n] = *(const f32x4*)(xin + off + 128 * bj + 4 * n); }
#pragma unroll
        for (int g = 0; g < 8; ++g) { const int ai = g >> 2, m = g & 3;
            if (g < 7) { const size_t offn = (size_t)(row0 + ((g + 1) >> 2) * 128 + ((g + 1) & 3) * 16) * D + c0;
#pragma unroll
                for (int bj = 0; bj < 2; ++bj)
#pragma unroll
                    for (int n = 0; n < 2; ++n) nxt[bj][n] = *(const f32x4*)(xin + offn + 128 * bj + 4 * n); }
            const size_t off = (size_t)(row0 + ai * 128 + m * 16) * D + c0;
#pragma unroll
            for (int bj = 0; bj < 2; ++bj)
#pragma unroll
                for (int n = 0; n < 2; ++n) *(f32x4*)(xout + off + 128 * bj + 4 * n) = cur[bj][n] + gv[bj][n] * acc[ai][bj][m][n] * scale;
#pragma unroll
            for (int bj = 0; bj < 2; ++bj)
#pragma unroll
                for (int n = 0; n < 2; ++n) cur[bj][n] = nxt[bj][n];
            asm volatile("" ::: "memory"); }
    }
};
struct EpiGU {
    bf16_t* ACT;
    __device__ __forceinline__ void operator()(AccRef acc, const pg8::Unit& u, int wr, int wc, int fr, int fq) const {
        const int row0 = u.pm * 256 + wr * 64 + fr, cA = 128 * u.pn + wc * 32 + fq * 8;
#pragma unroll
        for (int ai = 0; ai < 2; ++ai)
#pragma unroll
            for (int m = 0; m < 4; ++m) { f32x4 r[2];
#pragma unroll
                for (int n = 0; n < 2; ++n) { const f32x4 a = acc[ai][0][m][n], b = acc[ai][1][m][n];
#pragma unroll
                    for (int j = 0; j < 4; ++j) r[n][j] = a[j] * sigm(a[j]) * b[j]; }
                *(u32x4*)(ACT + (size_t)(row0 + ai * 128 + m * 16) * DFF + cA) = pack8(r[0], r[1]); }
    }
};

__device__ __forceinline__ void p0_mod(const Args& a, float* mod, LAS unsigned char* lds, int item, int tid, int lane, int wave) {
    LAS float* cs = (LAS float*)lds; LAS float* red = (LAS float*)(lds + 32768);
    for (int i = tid; i < NB * D; i += 512) { const int b = i >> 10, k = i & 1023; const float v = a.c[i]; cs[k * 8 + b] = v * sigm(v); }
    __syncthreads();
    const int jl = lane & 31, j = item * 32 + jl, kg = wave * 2 + (lane >> 5);
    float s0 = 0.f, s1 = 0.f, s2 = 0.f, s3 = 0.f, s4 = 0.f, s5 = 0.f, s6 = 0.f, s7 = 0.f;
#pragma unroll 8
    for (int kk = 0; kk < 64; ++kk) { const int k = kg * 64 + kk; const float w = a.w_ada[(size_t)k * NMOD + j];
        const f32x4 c0 = *(const LAS f32x4*)(cs + k * 8), c1 = *(const LAS f32x4*)(cs + k * 8 + 4);
        s0 += w * c0[0]; s1 += w * c0[1]; s2 += w * c0[2]; s3 += w * c0[3]; s4 += w * c1[0]; s5 += w * c1[1]; s6 += w * c1[2]; s7 += w * c1[3]; }
    red[(kg * 8 + 0) * 32 + jl] = s0; red[(kg * 8 + 1) * 32 + jl] = s1; red[(kg * 8 + 2) * 32 + jl] = s2; red[(kg * 8 + 3) * 32 + jl] = s3;
    red[(kg * 8 + 4) * 32 + jl] = s4; red[(kg * 8 + 5) * 32 + jl] = s5; red[(kg * 8 + 6) * 32 + jl] = s6; red[(kg * 8 + 7) * 32 + jl] = s7;
    __syncthreads();
    if (tid < 256) { const int b = tid >> 5, jj = tid & 31; float s = 0.f;
#pragma unroll
        for (int g = 0; g < 16; ++g) s += red[(g * 8 + b) * 32 + jj];
        mod[(size_t)b * NMOD + item * 32 + jj] = s + a.b_ada[item * 32 + jj]; }
    __syncthreads();
}
__device__ __forceinline__ void transpose_item(const float* W, int K, int N, bf16_t* WT, int k0, int nsrc0, int rdst0, LAS float* scr, int lane) {
#pragma unroll 8
    for (int i = 0; i < 32; ++i) { const int kk = 2 * i + (lane >> 5); scr[kk * 33 + (lane & 31)] = W[(size_t)(k0 + kk) * N + nsrc0 + (lane & 31)]; }
    asm volatile("s_waitcnt lgkmcnt(0)" ::: "memory");
    const int c = lane & 7;
#pragma unroll
    for (int j = 0; j < 4; ++j) { const int n = (lane >> 3) + 8 * j; const LAS float* s = scr + (8 * c) * 33 + n;
        u32x4 o; o.x = cvt_pk_bf16(s[0 * 33], s[1 * 33]); o.y = cvt_pk_bf16(s[2 * 33], s[3 * 33]); o.z = cvt_pk_bf16(s[4 * 33], s[5 * 33]); o.w = cvt_pk_bf16(s[6 * 33], s[7 * 33]);
        *(u32x4*)(WT + (size_t)(rdst0 + n) * K + k0 + 8 * c) = o; }
    asm volatile("s_waitcnt lgkmcnt(0)" ::: "memory");
}
__device__ __forceinline__ void p0_convert(const Args& a, unsigned char* ws, LAS unsigned char* lds, int gw, int NGW, int wave, int lane) {
    LAS float* scr = (LAS float*)(lds + 49152 + wave * 8448);
    constexpr int I_IN = (D / 64) * (DIN / 32), I_A = (DC / 64) * (D / 32), I_B = I_A, I_O = (D / 64) * (D / 32), I_GU = (D / 64) * (NGU / 32), I_DN = (DFF / 64) * (D / 32);
    constexpr int NITEMS = I_IN + I_A + I_B + I_O + I_GU + I_DN;
    for (int it = gw; it < NITEMS; it += NGW) {
        int r = it;
        if (r < I_IN) { const int nblk = DIN / 32, kb = r / nblk, nb = r % nblk; transpose_item(a.w_in, D, DIN, (bf16_t*)(ws + WS_WIN), 64 * kb, map_in(32 * nb), 32 * nb, scr, lane); continue; } r -= I_IN;
        if (r < I_A) { const int nblk = D / 32, kb = r / nblk, nb = r % nblk; transpose_item(a.conf_w_out, DC, D, (bf16_t*)(ws + WS_WA), 64 * kb, 32 * nb, 32 * nb, scr, lane); continue; } r -= I_A;
        if (r < I_B) { const int nblk = D / 32, kb = r / nblk, nb = r % nblk; transpose_item(a.sc_w_out, DC, D, (bf16_t*)(ws + WS_WB), 64 * kb, 32 * nb, 32 * nb, scr, lane); continue; } r -= I_B;
        if (r < I_O) { const int nblk = D / 32, kb = r / nblk, nb = r % nblk; transpose_item(a.w_o, D, D, (bf16_t*)(ws + WS_WO), 64 * kb, 32 * nb, 32 * nb, scr, lane); continue; } r -= I_O;
        if (r < I_GU) { const int nblk = NGU / 32, kb = r / nblk, nb = r % nblk; transpose_item(a.w_gu, D, NGU, (bf16_t*)(ws + WS_WGU), 64 * kb, map_gu(32 * nb), 32 * nb, scr, lane); continue; } r -= I_GU;
        { const int nblk = D / 32, kb = r / nblk, nb = r % nblk; transpose_item(a.w_down, DFF, D, (bf16_t*)(ws + WS_WDN), 64 * kb, 32 * nb, 32 * nb, scr, lane); }
    }
}
__device__ __forceinline__ int own_row(int i, int wave, int G, int c) { return (G == 256) ? (c & 7) * SEQ + (c >> 3) * 64 + wave * 8 + i : (c * 8 + wave) + i * (G * 8); }
__device__ __forceinline__ int own_cnt(int G) { return (G == 256) ? 8 : (M + G * 8 - 1) / (G * 8); }
__device__ __forceinline__ float sumsq4(const f32x4 (&v)[4]) { float ss = 0.f;
#pragma unroll
    for (int j = 0; j < 4; ++j) ss += (v[j][0] * v[j][0] + v[j][1] * v[j][1]) + (v[j][2] * v[j][2] + v[j][3] * v[j][3]);
    return ss; }
__device__ __forceinline__ void rownorm_mod(const float* X, const float* g, const float* mod, int sh_off, int sc_off, bf16_t* out, int wave, int G, int lane, int vid) {
    if (G == 256) {
        const int b = vid & 7, m0 = b * SEQ + (vid >> 3) * 64 + wave * 8; f32x4 mul[4], sh[4];
#pragma unroll
        for (int j = 0; j < 4; ++j) { const int col = 4 * lane + 256 * j; const f32x4 gv = *(const f32x4*)(g + col), sc = *(const f32x4*)(mod + (size_t)b * NMOD + sc_off + col);
            sh[j] = *(const f32x4*)(mod + (size_t)b * NMOD + sh_off + col); mul[j] = gv * (sc + 1.0f); }
        f32x4 cur[4], nxt[4];
#pragma unroll
        for (int j = 0; j < 4; ++j) cur[j] = ((const f32x4*)(X + (size_t)m0 * D) + lane)[64 * j];
#pragma unroll
        for (int it = 0; it < 8; ++it) { const int m = m0 + it;
            if (it < 7) {
#pragma unroll
                for (int j = 0; j < 4; ++j) nxt[j] = ((const f32x4*)(X + (size_t)(m + 1) * D) + lane)[64 * j]; }
            const float rstd = rsqrtf(wave_sum(sumsq4(cur)) * (1.f / D) + RMS_EPS);
            u32x2* o8 = (u32x2*)(out + (size_t)m * D) + lane;
#pragma unroll
            for (int j = 0; j < 4; ++j) { const f32x4 o = cur[j] * rstd * mul[j] + sh[j]; u32x2 w; w.x = cvt_pk_bf16(o[0], o[1]); w.y = cvt_pk_bf16(o[2], o[3]); o8[64 * j] = w; }
#pragma unroll
            for (int j = 0; j < 4; ++j) cur[j] = nxt[j]; }
        return; }
    for (int it = 0; it < own_cnt(G); ++it) { const int m = own_row(it, wave, G, vid); if (m >= M) break;
        const int b = m >> 11; const f32x4* xr = (const f32x4*)(X + (size_t)m * D) + lane; f32x4 v[4];
#pragma unroll
        for (int j = 0; j < 4; ++j) v[j] = xr[64 * j];
        const float rstd = rsqrtf(wave_sum(sumsq4(v)) * (1.f / D) + RMS_EPS);
        u32x2* o8 = (u32x2*)(out + (size_t)m * D) + lane;
#pragma unroll
        for (int j = 0; j < 4; ++j) { const int col = 4 * lane + 256 * j; const f32x4 gv = *(const f32x4*)(g + col), sc = *(const f32x4*)(mod + (size_t)b * NMOD + sc_off + col), sh = *(const f32x4*)(mod + (size_t)b * NMOD + sh_off + col);
            const f32x4 o = v[j] * rstd * gv * (sc + 1.0f) + sh; u32x2 w; w.x = cvt_pk_bf16(o[0], o[1]); w.y = cvt_pk_bf16(o[2], o[3]); o8[64 * j] = w; }
    }
}
__device__ __forceinline__ void final_norm(const float* X, float* O, const float* g, int wave, int G, int lane, int vid) {
    f32x4 gv[4];
#pragma unroll
    for (int j = 0; j < 4; ++j) gv[j] = *(const f32x4*)(g + 4 * lane + 256 * j);
    const int cnt = own_cnt(G); f32x4 cur[4], nxt[4]; int m = own_row(0, wave, G, vid);
    if (m < M) {
#pragma unroll
        for (int j = 0; j < 4; ++j) cur[j] = ((const f32x4*)(X + (size_t)m * D) + lane)[64 * j]; }
    for (int it = 0; it < cnt && m < M; ++it) { const int mn = (it + 1 < cnt) ? own_row(it + 1, wave, G, vid) : M;
        if (mn < M) {
#pragma unroll
            for (int j = 0; j < 4; ++j) nxt[j] = ((const f32x4*)(X + (size_t)mn * D) + lane)[64 * j]; }
        const float rstd = rsqrtf(wave_sum(sumsq4(cur)) * (1.f / D) + RMS_EPS);
        f32x4* orow = (f32x4*)(O + (size_t)m * D) + lane;
#pragma unroll
        for (int j = 0; j < 4; ++j) orow[64 * j] = cur[j] * rstd * gv[j];
#pragma unroll
        for (int j = 0; j < 4; ++j) cur[j] = nxt[j];
        m = mn; }
}
__device__ __forceinline__ void p3_conv(const Args& a, unsigned char* ws, LAS unsigned char* lds, int tid, int lane, int wave, int vid) {
    const bf16_t* U = (const bf16_t*)(ws + WS_U); const unsigned* GCV = (const unsigned*)(ws + WS_GCV); const unsigned* GBp = (const unsigned*)(ws + WS_GB);
    unsigned* UA = (unsigned*)(ws + WS_UA); unsigned* VB = (unsigned*)(ws + WS_VB);
    LAS unsigned* buf = (LAS unsigned*)lds; LAS float* red = (LAS float*)(lds + 94 * 1024);
    const int cp = tid & 255, th = tid >> 8, w4 = wave & 3;
    f32x2 w[CONF_K];
#pragma unroll
    for (int k = 0; k < CONF_K; ++k) w[k] = *(const f32x2*)(a.conf_dw_w + k * DC + 2 * cp);
    const f32x2 cb = *(const f32x2*)(a.conf_dw_b + 2 * cp), lg = *(const f32x2*)(a.conf_ln_g + 2 * cp), lb = *(const f32x2*)(a.conf_ln_b + 2 * cp);
    const f32x2 w30 = *(const f32x2*)(a.sc_dw_w + 2 * cp), w31 = *(const f32x2*)(a.sc_dw_w + DC + 2 * cp), w32 = *(const f32x2*)(a.sc_dw_w + 2 * DC + 2 * cp);
    for (int tl = vid; tl < M / 64; tl += gridDim.x) {
        const int tile = (gridDim.x == 256) ? (tl & 7) * 32 + (tl >> 3) : tl;
        const int t0 = tile * 64, s0 = t0 & (SEQ - 1);
        __syncthreads();
        for (int ch = tid; ch < 94 * 64; ch += 512) { const int row = ch >> 6, c16 = ch & 63; u32x4 v = (u32x4){0u, 0u, 0u, 0u};
            if (s0 != 0 || row >= 30) v = *(const u32x4*)(U + (size_t)(t0 - 30 + row) * DC + c16 * 8);
            *(LAS u32x4*)(lds + row * 1024 + c16 * 16) = v; }
        __syncthreads();
#pragma unroll 1
        for (int chunk = 0; chunk < 4; ++chunk) {
            const int tb = t0 + th * 32 + chunk * 8; unsigned gc[10], gbv[8];
            { const bool head = ((tb & (SEQ - 1)) == 0);
              gc[0] = head ? 0u : GCV[(size_t)(tb - 2) * (DC / 2) + cp]; gc[1] = head ? 0u : GCV[(size_t)(tb - 1) * (DC / 2) + cp];
#pragma unroll
              for (int tt = 0; tt < 8; ++tt) { gc[2 + tt] = GCV[(size_t)(tb + tt) * (DC / 2) + cp]; gbv[tt] = GBp[(size_t)(tb + tt) * (DC / 2) + cp]; } }
            float y0[8], y1[8];
#pragma unroll
            for (int tt = 0; tt < 8; ++tt) { const int lt = th * 32 + chunk * 8 + tt; float a0 = cb[0], a1 = cb[1];
#pragma unroll
                for (int k = 0; k < CONF_K; ++k) { const unsigned v = buf[(lt + k) * 256 + cp]; a0 += w[k][0] * bf_lo(v); a1 += w[k][1] * bf_hi(v); }
                y0[tt] = a0; y1[tt] = a1; }
#pragma unroll
            for (int tt = 0; tt < 8; ++tt) { const float sq = wave_sum(y0[tt] + y1[tt]), q = wave_sum(y0[tt] * y0[tt] + y1[tt] * y1[tt]);
                if (lane == 0) { red[((tt * 2 + th) * 4 + w4) * 2 + 0] = sq; red[((tt * 2 + th) * 4 + w4) * 2 + 1] = q; } }
            __syncthreads();
#pragma unroll
            for (int tt = 0; tt < 8; ++tt) { const int lt = th * 32 + chunk * 8 + tt; const LAS float* r = red + (tt * 2 + th) * 8;
                const float S = (r[0] + r[2]) + (r[4] + r[6]), Q = (r[1] + r[3]) + (r[5] + r[7]);
                const float mean = S * (1.f / DC), var = fmaxf(Q * (1.f / DC) - mean * mean, 0.f), rstd = rsqrtf(var + LN_EPS);
                const float z0 = (y0[tt] - mean) * rstd * lg[0] + lb[0], z1 = (y1[tt] - mean) * rstd * lg[1] + lb[1];
                UA[(size_t)(t0 + lt) * (DC / 2) + cp] = cvt_pk_bf16(z0 * sigm(z0), z1 * sigm(z1)); }
#pragma unroll
            for (int tt = 0; tt < 8; ++tt) { const unsigned p2 = gc[tt], p1 = gc[tt + 1], cur = gc[tt + 2], gb = gbv[tt];
                const float r0 = w30[0] * bf_lo(p2) + w31[0] * bf_lo(p1) + w32[0] * bf_lo(cur), r1 = w30[1] * bf_hi(p2) + w31[1] * bf_hi(p1) + w32[1] * bf_hi(cur);
                VB[(size_t)(tb + tt) * (DC / 2) + cp] = cvt_pk_bf16(bf_lo(gb) * r0, bf_hi(gb) * r1); }
            __syncthreads();
        }
    }
}

template <int LO, int HI>
__device__ __forceinline__ void mega_body(const Args& a) {
    extern __shared__ __attribute__((aligned(16))) unsigned char lds_raw[];
    LAS unsigned char* lds = (LAS unsigned char*)lds_raw;
    const int G = gridDim.x;
#define PHASE_IDS const int tid = opaque_tid(), lane = tid & 63, wave = __builtin_amdgcn_readfirstlane(tid >> 6); (void)tid; (void)lane; (void)wave
    unsigned char* ws = a.ws; float* mod = (float*)(ws + WS_MOD);
    constexpr int lo = LO, hi = HI;
#define IN(k) (lo <= (k) && (k) < hi)
#define GRID_BARRIER(idx) do { asm volatile("s_waitcnt vmcnt(0) lgkmcnt(0)" ::: "memory"); __syncthreads(); \
        if (threadIdx.x == 0) { unsigned* bw = (unsigned*)a.ws + 1024 + 64 * (idx); __builtin_amdgcn_fence(__ATOMIC_RELEASE, "agent"); asm volatile("s_waitcnt vmcnt(0)" ::: "memory"); \
            __hip_atomic_fetch_add(bw, 1u, __ATOMIC_RELAXED, __HIP_MEMORY_SCOPE_AGENT); \
            while (__hip_atomic_load(bw, __ATOMIC_RELAXED, __HIP_MEMORY_SCOPE_AGENT) < gridDim.x) __builtin_amdgcn_s_sleep(1); \
            __builtin_amdgcn_fence(__ATOMIC_ACQUIRE, "agent"); asm volatile("s_waitcnt vmcnt(0)" ::: "memory"); } \
        __syncthreads(); asm volatile("" ::: "memory"); } while (0)
#define SEAM(k) do { if (IN(k) && IN((k) + 1)) GRID_BARRIER(k); } while (0)
    volatile LAS unsigned* misc = (volatile LAS unsigned*)(lds + 131072);
    unsigned* ctl = (unsigned*)ws;
    if (lo == 0 && hi > 1) cg::this_grid().sync();
    if (threadIdx.x == 0) misc[3] = 0u;
    if (lo == 0) { if (threadIdx.x == 0) { const unsigned xcc = (unsigned)__builtin_amdgcn_s_getreg((3 << 11) | 20) & 0xFu;
            misc[0] = xcc; misc[1] = __hip_atomic_fetch_add(ctl + 64 * xcc, 1u, __ATOMIC_RELAXED, __HIP_MEMORY_SCOPE_AGENT); misc[2] = blockIdx.x; } }
    else { if (threadIdx.x == 0) misc[2] = blockIdx.x; }
#define VID ((int)misc[2])
    if (IN(0)) { PHASE_IDS; const int gw = blockIdx.x * 8 + wave, NGW = G * 8;
        if (G >= 256) { if (blockIdx.x < 192) p0_mod(a, mod, lds, blockIdx.x, tid, lane, wave); }
        else { for (int it = blockIdx.x; it < 192; it += G) p0_mod(a, mod, lds, it, tid, lane, wave); }
        p0_convert(a, ws, lds, gw, NGW, wave, lane);
    }
    SEAM(0);
    if (lo == 0 && hi > 1) { if (threadIdx.x == 0) { bool even = (G == 256);
            for (int j = 0; j < 16; ++j) { const unsigned cnt = __hip_atomic_load(ctl + 64 * j, __ATOMIC_RELAXED, __HIP_MEMORY_SCOPE_AGENT); if (cnt != (j < 8 ? 32u : 0u)) even = false; }
            if (even) misc[2] = misc[1] * 8u + misc[0]; else misc[3] = 1u; } }
    __syncthreads();
    if (IN(1)) { PHASE_IDS; rownorm_mod(a.x, a.norm1_g, mod, MO_SH1, MO_SC1, (bf16_t*)(ws + WS_A1), wave, G, lane, VID); }
    SEAM(1);
    if (IN(2)) {
        pg8::Gemm g{(const bf16_t*)(ws + WS_A1), (const bf16_t*)(ws + WS_WIN), nullptr, nullptr, D}; pg8::Order S; S.init(M, DIN, G, VID, 0);
        EpiIn E{(bf16_t*)(ws + WS_U), (bf16_t*)(ws + WS_GB), (bf16_t*)(ws + WS_GCV), (bf16_t*)(ws + WS_GATES), a.b_glu, a.b_gate};
        pg8::gemm_phase(lds, g, S, E);
    }
    SEAM(2);
    if (IN(3)) { PHASE_IDS; p3_conv(a, ws, lds, tid, lane, wave, VID); }
    SEAM(3);
    if (IN(4)) {
        pg8::Gemm g{(const bf16_t*)(ws + WS_UA), (const bf16_t*)(ws + WS_WA), (const bf16_t*)(ws + WS_VB), (const bf16_t*)(ws + WS_WB), DC}; pg8::Order S; S.init(M, D, G, VID, 1);
        EpiDual E{(bf16_t*)(ws + WS_T), (bf16_t*)(ws + WS_MIX), (const bf16_t*)(ws + WS_GATES), a.conf_b_out, -1};
        pg8::gemm_phase(lds, g, S, E);
    }
    SEAM(4);
    if (IN(5)) {
        pg8::Gemm g{(const bf16_t*)(ws + WS_MIX), (const bf16_t*)(ws + WS_WO), nullptr, nullptr, D}; pg8::Order S; S.init(M, D, G, VID, 0);
        #if STOP_AFTER == 5
        EpiRes E{(const float*)(ws + WS_ACT), a.out, mod + MO_GT1, 8.0f};
#else
        EpiRes E{a.x, (float*)(ws + WS_X1), mod + MO_GT1, 1.0f};
#endif
        pg8::gemm_phase(lds, g, S, E);
    }
    SEAM(5);
    if (IN(6)) { PHASE_IDS; rownorm_mod((const float*)(ws + WS_X1), a.norm2_g, mod, MO_SH2, MO_SC2, (bf16_t*)(ws + WS_A1), wave, G, lane, VID); }
    SEAM(6);
    if (IN(7)) {
        pg8::Gemm g{(const bf16_t*)(ws + WS_A1), (const bf16_t*)(ws + WS_WGU), nullptr, nullptr, D}; pg8::Order S; S.init(M, NGU, G, VID, 0);
        EpiGU E{(bf16_t*)(ws + WS_ACT)};
        pg8::gemm_phase(lds, g, S, E);
    }
    SEAM(7);
    if (IN(8)) {
        pg8::Gemm g{(const bf16_t*)(ws + WS_ACT), (const bf16_t*)(ws + WS_WDN), nullptr, nullptr, DFF}; pg8::Order S; S.init(M, D, G, VID, 0);
        EpiRes E{(const float*)(ws + WS_X1), (float*)(ws + WS_X1), mod + MO_GT2, 1.0f};
        pg8::gemm_phase(lds, g, S, E);
    }
#ifdef DUMP_IN_KERNEL
    if (hi == 8) { asm volatile("s_waitcnt vmcnt(0) lgkmcnt(0)" ::: "memory"); cg::this_grid().sync(); __builtin_amdgcn_fence(__ATOMIC_ACQUIRE, "agent"); asm volatile("s_waitcnt vmcnt(0)" ::: "memory");
        PHASE_IDS; const bf16_t* ACTp = (const bf16_t*)(ws + WS_ACT);
        for (int it = 0; it < own_cnt(G); ++it) { const int m = own_row(it, wave, G, VID); if (m >= M) break;
            for (int j = 0; j < 16; ++j) a.out[(size_t)m * D + j * 64 + lane] = bf2f(ACTp[(size_t)m * DFF + j * 64 + lane]); } }
    if (hi == 7) { asm volatile("s_waitcnt vmcnt(0) lgkmcnt(0)" ::: "memory"); cg::this_grid().sync(); __builtin_amdgcn_fence(__ATOMIC_ACQUIRE, "agent"); asm volatile("s_waitcnt vmcnt(0)" ::: "memory");
        PHASE_IDS; const bf16_t* Ap = (const bf16_t*)(ws + WS_A1);
        for (int it = 0; it < own_cnt(G); ++it) { const int m = own_row(it, wave, G, VID); if (m >= M) break;
            for (int j = 0; j < 16; ++j) a.out[(size_t)m * D + j * 64 + lane] = bf2f(Ap[(size_t)m * D + j * 64 + lane]); } }
#endif
    SEAM(8);
    if (IN(9)) { PHASE_IDS; final_norm((const float*)(ws + WS_X1), a.out, a.final_g, wave, G, lane, VID); }
    if (hi == 10 && threadIdx.x == 0 && misc[3] != 0u) { asm volatile("s_waitcnt vmcnt(0)" ::: "memory"); a.out[(size_t)blockIdx.x * 4096] = __builtin_nanf(""); }
#ifdef XCC_PROBE
    { const unsigned xcc = (unsigned)__builtin_amdgcn_s_getreg((3 << 11) | 20) & 0xFu;
      if (xcc != (blockIdx.x & 7u) && threadIdx.x == 0) { asm volatile("s_waitcnt vmcnt(0)" ::: "memory"); a.out[(size_t)blockIdx.x * 4096] = __builtin_nanf(""); } }
#endif
#undef IN
#undef SEAM
}
__global__ void dump_bf16(const bf16_t* src, float* out, int n) { for (int i = blockIdx.x * blockDim.x + threadIdx.x; i < n; i += gridDim.x * blockDim.x) out[i] = DUMP_SCALE * bf2f(src[i]); }
__global__ void dump_f32(const float* src, int nsrc, float* out, int n) { for (int i = blockIdx.x * blockDim.x + threadIdx.x; i < n; i += gridDim.x * blockDim.x) out[i] = DUMP_SCALE * src[i % nsrc]; }
__global__ void __launch_bounds__(512, 2) mega(Args a) { mega_body<0, STOP_AFTER + 1>(a); }
#if MODE != 2
template <int PH> __global__ void __launch_bounds__(512, 2) mega_ph(Args a) { mega_body<PH, PH + 1>(a); }
template <int PH> static void launch_ph(const Args& a, int grid, hipStream_t stream) {
    static bool once = false; if (!once) { once = true; (void)hipFuncSetAttribute((const void*)mega_ph<PH>, hipFuncAttributeMaxDynamicSharedMemorySize, LDS_BYTES); }
    mega_ph<PH><<<dim3(grid), dim3(512), LDS_BYTES, stream>>>(a);
}
#endif

struct NaiveEpi { int kind; const Args* dummy; const float *p0, *p1, *p2; bf16_t *o0, *o1, *o2, *o3; const bf16_t* g; float* fo; };
__device__ __forceinline__ int ne_c0(int kind, int lc) { if (kind == 2) { if (lc < 512) return lc; if (lc < 1024) return 1024 + (lc - 512); if (lc < 1536) return 1536 + (lc - 1024); return 2560 + (lc - 1536); } return lc; }
__device__ __forceinline__ int ne_c1(int kind, int lc) { if (kind == 2) { if (lc < 512) return 512 + lc; if (lc < 1024) return 1024 + (lc - 512); if (lc < 1536) return 2048 + (lc - 1024); return 2560 + (lc - 1536); } if (kind == 7) return DFF + lc; return lc; }
template <bool DUAL>
__global__ void __launch_bounds__(256) naive_gemm(const bf16_t* A0, const float* W0, int ldw0, const bf16_t* A1, const float* W1, int ldw1, int K, NaiveEpi e) {
    const int lc = blockIdx.x * 256 + threadIdx.x, r0 = blockIdx.y * 16;
    const int c0 = ne_c0(e.kind, lc), c1 = ne_c1(e.kind, lc);
    float a0[16], a1[16];
#pragma unroll
    for (int i = 0; i < 16; ++i) { a0[i] = 0.f; a1[i] = 0.f; }
    for (int k = 0; k < K; k += 2) {
        const float w00 = W0[(size_t)k * ldw0 + c0], w01 = W0[(size_t)(k + 1) * ldw0 + c0];
        float w10 = 0.f, w11 = 0.f; if (DUAL) { w10 = W1[(size_t)k * ldw1 + c1]; w11 = W1[(size_t)(k + 1) * ldw1 + c1]; }
#pragma unroll
        for (int i = 0; i < 16; ++i) { const unsigned av = *(const volatile unsigned*)(A0 + (size_t)(r0 + i) * K + k); a0[i] += bf_lo(av) * w00 + bf_hi(av) * w01;
            if (DUAL) { const unsigned bv = *(const volatile unsigned*)(A1 + (size_t)(r0 + i) * K + k); a1[i] += bf_lo(bv) * w10 + bf_hi(bv) * w11; } }
    }
#pragma unroll
    for (int i = 0; i < 16; ++i) { const size_t row = (size_t)(r0 + i); const int b = (r0 + i) >> 11; const float v0 = a0[i], v1 = a1[i];
        if (e.kind == 2) {
            if (lc < 512) e.o0[row * DC + lc] = f2bf((v0 + e.p0[lc]) * sigm(v1 + e.p0[512 + lc]));
            else if (lc < 1024) e.o1[row * DC + (lc - 512)] = f2bf(v0);
            else if (lc < 1536) e.o2[row * DC + (lc - 1024)] = f2bf(v0 * v1);
            else e.o3[row * 2048 + (lc - 1536)] = f2bf(sigm(v0 + e.p1[lc - 1536]));
        } else if (e.kind == 4) { const float ga = bf2f(e.g[row * 2048 + lc]), gb = bf2f(e.g[row * 2048 + 1024 + lc]); e.o0[row * D + lc] = f2bf(ga * (v0 + e.p0[lc]) + gb * v1);
        } else if (e.kind == 5 || e.kind == 8) { e.fo[row * D + lc] = e.p2[row * D + lc] + e.p0[(size_t)b * NMOD + lc] * v0;
        } else if (e.kind == 7) { e.o0[row * DFF + lc] = f2bf(v0 * sigm(v0) * v1); }
    }
}

extern "C" void kernel_launch(void* const* d_in, const int* in_sizes, int n_in, void* d_out, int out_size, void* d_ws, size_t ws_size, hipStream_t stream) {
    static int grid = 0;
    if (grid == 0) {
        if (n_in != 21 || out_size != M * D || ws_size < WS_END) { fprintf(stderr, "kernel_launch: unexpected shapes (n_in %d out %d ws %zu)\n", n_in, out_size, ws_size); grid = -1; return; }
        int dev = 0, cus = 0, per_cu = 0;
        hipGetDevice(&dev); hipDeviceGetAttribute(&cus, hipDeviceAttributeMultiprocessorCount, dev);
        if (hipFuncSetAttribute((const void*)mega, hipFuncAttributeMaxDynamicSharedMemorySize, LDS_BYTES) != hipSuccess) { fprintf(stderr, "kernel_launch: hipFuncSetAttribute failed\n"); grid = -1; return; }
        if (hipOccupancyMaxActiveBlocksPerMultiprocessor(&per_cu, (const void*)mega, 512, LDS_BYTES) != hipSuccess || per_cu < 1) { fprintf(stderr, "kernel_launch: occupancy query gave %d\n", per_cu); per_cu = 1; }
        (void)hipGetLastError();
        grid = cus * per_cu;
    }
    if (grid < 0) return;
    Args a{};
    const float** ap = (const float**)&a;
    for (int i = 0; i < 21; ++i) ap[i] = (const float*)d_in[i];
    a.out = (float*)d_out; a.ws = (unsigned char*)d_ws;
    unsigned char* ws = (unsigned char*)d_ws; float* mod = (float*)(ws + WS_MOD); (void)mod;
    (void)hipMemsetAsync(d_ws, 0, 8192, stream);
#ifdef EXP_MEMSET
    (void)hipMemsetAsync((char*)d_ws + 8192, 0, 256 * MiB - 8192, stream); (void)hipMemsetAsync(d_out, 0, (size_t)M * D * 4, stream);
#endif
#if MODE == 2
    a.ph_lo = 0; a.ph_hi = 10;
    { void* args[] = {&a}; hipError_t e = hipLaunchCooperativeKernel((const void*)mega, dim3(grid), dim3(512), args, LDS_BYTES, stream);
      if (e != hipSuccess) fprintf(stderr, "cooperative launch failed: %s (grid %d)\n", hipGetErrorString(e), grid); }
#else
    const unsigned naive_mask = (MODE == 0) ? 0x1B4u : (unsigned)(NAIVE_MASK);
    for (int ph = 0; ph <= STOP_AFTER; ++ph) {
        if (naive_mask & (1u << ph)) {
            NaiveEpi e{}; e.kind = ph;
            if (ph == 2) { e.p0 = a.b_glu; e.p1 = a.b_gate; e.o0 = (bf16_t*)(ws + WS_U); e.o1 = (bf16_t*)(ws + WS_GB); e.o2 = (bf16_t*)(ws + WS_GCV); e.o3 = (bf16_t*)(ws + WS_GATES);
                naive_gemm<true><<<dim3(3584 / 256, M / 16), 256, 0, stream>>>((const bf16_t*)(ws + WS_A1), a.w_in, DIN, (const bf16_t*)(ws + WS_A1), a.w_in, DIN, D, e); }
            else if (ph == 4) { e.p0 = a.conf_b_out; e.g = (const bf16_t*)(ws + WS_GATES); e.o0 = (bf16_t*)(ws + WS_MIX);
                naive_gemm<true><<<dim3(D / 256, M / 16), 256, 0, stream>>>((const bf16_t*)(ws + WS_UA), a.conf_w_out, D, (const bf16_t*)(ws + WS_VB), a.sc_w_out, D, DC, e); }
            else if (ph == 5) { e.p0 = mod + MO_GT1; e.p2 = a.x; e.fo = (float*)(ws + WS_X1);
                naive_gemm<false><<<dim3(D / 256, M / 16), 256, 0, stream>>>((const bf16_t*)(ws + WS_MIX), a.w_o, D, nullptr, nullptr, 0, D, e); }
            else if (ph == 7) { e.o0 = (bf16_t*)(ws + WS_ACT);
                naive_gemm<true><<<dim3(DFF / 256, M / 16), 256, 0, stream>>>((const bf16_t*)(ws + WS_A1), a.w_gu, NGU, (const bf16_t*)(ws + WS_A1), a.w_gu, NGU, D, e); }
            else if (ph == 8) { e.p0 = mod + MO_GT2; e.p2 = (const float*)(ws + WS_X1); e.fo = (float*)(ws + WS_X1);
                naive_gemm<false><<<dim3(D / 256, M / 16), 256, 0, stream>>>((const bf16_t*)(ws + WS_ACT), a.w_down, D, nullptr, nullptr, 0, DFF, e); }
        } else {
            switch (ph) { case 0: launch_ph<0>(a, grid, stream); break; case 1: launch_ph<1>(a, grid, stream); break; case 2: launch_ph<2>(a, grid, stream); break; case 3: launch_ph<3>(a, grid, stream); break;
                case 4: launch_ph<4>(a, grid, stream); break; case 5: launch_ph<5>(a, grid, stream); break; case 6: launch_ph<6>(a, grid, stream); break; case 7: launch_ph<7>(a, grid, stream); break;
                case 8: launch_ph<8>(a, grid, stream); break; default: launch_ph<9>(a, grid, stream); break; }
        }
    }
#endif
    if (STOP_AFTER == 0) dump_f32<<<1024, 256, 0, stream>>>(mod, NB * NMOD, a.out, M * D);
    else if (STOP_AFTER == 1) dump_bf16<<<1024, 256, 0, stream>>>((const bf16_t*)(ws + WS_A1), a.out, M * D);
    else if (STOP_AFTER == 2) dump_bf16<<<1024, 256, 0, stream>>>((const bf16_t*)(ws + WS_GATES), a.out, M * D);
    else if (STOP_AFTER == 3) dump_bf16<<<1024, 256, 0, stream>>>((const bf16_t*)(ws + WS_UA), a.out, M * D);
    else if (STOP_AFTER == 4) dump_bf16<<<1024, 256, 0, stream>>>((const bf16_t*)(ws + (PROBE_NOGATE ? WS_T : WS_MIX)), a.out, M * D);
    else if (STOP_AFTER == 6 && MODE != 2) dump_bf16<<<1024, 256, 0, stream>>>((const bf16_t*)(ws + WS_A1), a.out, M * D);
    else if (STOP_AFTER == 7 && MODE != 2) dump_bf16<<<1024, 256, 0, stream>>>((const bf16_t*)(ws + WS_ACT), a.out, M * D);
}
```

```cpp
#include <hip/hip_runtime.h>
#include <hip/hip_cooperative_groups.h>
#include <cstdio>
#include <cstdint>
namespace cg = cooperative_groups;


#define LAS __attribute__((address_space(3)))
typedef unsigned short bf16_t;
typedef short bf16x8 __attribute__((ext_vector_type(8)));
typedef float f32x4 __attribute__((ext_vector_type(4)));
typedef float f32x2 __attribute__((ext_vector_type(2)));
typedef unsigned u32x4 __attribute__((ext_vector_type(4)));
typedef unsigned u32x2 __attribute__((ext_vector_type(2)));

constexpr int NB = 8, SEQ = 2048, D = 1024, M = NB * SEQ, DC = 512, DIN = 4608, DFF = 2816, NGU = 2 * DFF, NMOD = 6 * D;
constexpr int CONF_K = 31;
constexpr float RMS_EPS = 1e-6f, LN_EPS = 1e-5f;
constexpr int MO_SH1 = 0, MO_SC1 = D, MO_GT1 = 2 * D, MO_SH2 = 3 * D, MO_SC2 = 4 * D, MO_GT2 = 5 * D;

constexpr size_t MiB = 1u << 20;
constexpr size_t WS_MOD = 1 * MiB;
constexpr size_t WS_WIN = 8 * MiB;
constexpr size_t WS_WA = 17 * MiB;
constexpr size_t WS_WB = 18 * MiB;
constexpr size_t WS_WO = 19 * MiB;
constexpr size_t WS_WGU = 21 * MiB;
constexpr size_t WS_WDN = 32 * MiB;
constexpr size_t WS_ARENA = 40 * MiB, ARENA = 24 * MiB;
constexpr size_t AO_A1 = 0;
constexpr size_t AO_UA = 0, AO_VB = 2 * MiB;
constexpr size_t AO_U = 4 * MiB, AO_GCV = 6 * MiB, AO_GB = 8 * MiB;
constexpr size_t AO_T = 4 * MiB;
constexpr size_t AO_MIX = 10 * MiB;
constexpr size_t AO_ACT = 4 * MiB;
constexpr size_t AO_GATES = 15 * MiB;
constexpr size_t AO_X1 = 15 * MiB;
constexpr size_t WS_END = WS_ARENA + 8 * ARENA;
constexpr int LDS_BYTES = 131072 + 2048;

struct Args {
    const float *x, *c, *w_ada, *b_ada, *norm1_g, *w_in, *b_glu, *conf_dw_w, *conf_dw_b, *conf_ln_g, *conf_ln_b, *conf_w_out, *conf_b_out,
        *sc_dw_w, *sc_w_out, *b_gate, *w_o, *norm2_g, *w_gu, *w_down, *final_g;
    float* out; unsigned char* ws; int ph_lo, ph_hi;
};

__device__ __forceinline__ float bf_lo(unsigned v) { return __uint_as_float(v << 16); }
__device__ __forceinline__ float bf_hi(unsigned v) { return __uint_as_float(v & 0xffff0000u); }
__device__ __forceinline__ float bf2f(bf16_t v) { return __uint_as_float(((unsigned)v) << 16); }
typedef __bf16 bf16x2_t __attribute__((ext_vector_type(2)));
__device__ __forceinline__ unsigned cvt_pk_bf16(float lo, float hi) { const f32x2 v = {lo, hi}; const bf16x2_t b = __builtin_convertvector(v, bf16x2_t); return __builtin_bit_cast(unsigned, b); }
__device__ __forceinline__ bf16_t f2bf(float f) { return (bf16_t)(cvt_pk_bf16(f, 0.f) & 0xffffu); }
__device__ __forceinline__ u32x4 pack8(const f32x4 a, const f32x4 b) { u32x4 w; w.x = cvt_pk_bf16(a[0], a[1]); w.y = cvt_pk_bf16(a[2], a[3]); w.z = cvt_pk_bf16(b[0], b[1]); w.w = cvt_pk_bf16(b[2], b[3]); return w; }
__device__ __forceinline__ void unpack8(const u32x4 w, f32x4& a, f32x4& b) { a[0] = bf_lo(w.x); a[1] = bf_hi(w.x); a[2] = bf_lo(w.y); a[3] = bf_hi(w.y); b[0] = bf_lo(w.z); b[1] = bf_hi(w.z); b[2] = bf_lo(w.w); b[3] = bf_hi(w.w); }
__device__ __forceinline__ float sigm(float x) { return __builtin_amdgcn_rcpf(1.0f + __builtin_amdgcn_exp2f(-1.4426950408889634f * x)); }
__device__ __forceinline__ int opaque_tid() { int t = threadIdx.x; asm volatile("" : "+v"(t)); return t; }
__device__ __forceinline__ float wave_sum(float v) {
#pragma unroll
    for (int o = 1; o < 64; o <<= 1) v += __shfl_xor(v, o);
    return v;
}
__device__ __forceinline__ int map_in(int r) {
    const int t = r >> 8, j = r & 255, h = j >> 7, jj = j & 127;
    if (t < 4) return h * 512 + 128 * t + jj;
    if (t < 6) return 1024 + 256 * (t - 4) + j;
    if (t < 10) return (h ? 2048 : 1536) + 128 * (t - 6) + jj;
    return 2560 + 256 * (t - 10) + j;
}
__device__ __forceinline__ int map_gu(int r) { const int t = r >> 8, j = r & 255, h = j >> 7, jj = j & 127; return h * DFF + 128 * t + jj; }

namespace pg8 {
constexpr int BM = 256, BK = 64, HALF = 128, HTB = HALF * BK * 2, STAGE_BYTES = 8 * HTB, NXCD = 8, WGM = 8;
__device__ __forceinline__ int lds_byte(int r, int c) { const int st = (r >> 4) * 2 + (c >> 5), rr = r & 15, cc = c & 31, ob = rr * 64 + cc * 2; return st * 1024 + (ob ^ (((ob >> 9) & 1) << 5)); }
__device__ __forceinline__ void stage_rc(int b, int& R, int& C) { const int st = b / 1024, sb = b % 1024, swz = sb ^ (((sb >> 9) & 1) << 5); R = (st >> 1) * 16 + swz / 64; C = (st & 1) * 32 + (swz % 64) / 2; }
__device__ __forceinline__ int perm32(int rho) { const int n = rho >> 4, i = rho & 15; return 8 * (i >> 2) + 4 * n + (i & 3); }

struct Unit { int pm, pn, sel; };
struct Gemm { const unsigned char* arena; unsigned offA0, offA1; const bf16_t *B0, *B1; int K; };

struct Order {
    int nM, nN, nwg, G, c, dual;
    __device__ void init(int M_, int N_, int G_, int c_, int dual_) { nM = M_ / BM; nN = N_ / BM; nwg = nM * nN; G = G_; c = c_; dual = dual_; }
    __device__ bool next(int i, Unit& u) const {
        const int ii = dual ? (i >> 1) : i;
        const long L = (long)ii * G + c; if (L >= nwg) return false;
        int wgid = (int)L; { const int q = nwg / NXCD, r = nwg % NXCD, xcd = wgid % NXCD, off = wgid / NXCD; wgid = (xcd < r ? xcd * (q + 1) : r * (q + 1) + (xcd - r) * q) + off; }
        const int nig = WGM * nN, gid = wgid / nig, fm = gid * WGM, gsz = (nM - fm) < WGM ? (nM - fm) : WGM;
        u.pm = fm + ((wgid % nig) % gsz); u.pn = (wgid % nig) / gsz; u.sel = dual ? (i & 1) : 0; return true;
    }
};

template <class Epi>
__device__ __forceinline__ void gemm_phase(LAS unsigned char* lds, const Gemm g, const Order& S, const Epi& E) {
    const int tid = opaque_tid(), wid = __builtin_amdgcn_readfirstlane(tid >> 6), lane = tid & 63, wr = wid >> 2, wc = wid & 3, fr = lane & 15, fq = lane >> 4;
    const int K = g.K, nt = K / BK;
    unsigned voffA[2], voffB[2];
#pragma unroll
    for (int i = 0; i < 2; ++i) { int R, C; stage_rc(tid * 16 + i * 8192, R, C); const int Rb = (R & ~31) + perm32(R & 31);
        voffA[i] = (unsigned)(R * K + C) * 2u; voffB[i] = (unsigned)(Rb * K + C) * 2u; }
    const size_t kstep = (size_t)(BK * 2);
    const size_t hstep = (size_t)HALF * K * 2;
    const size_t tstep = 2 * hstep;
    const unsigned ldsw = (unsigned)wid * 1024u;
    const int aoff = lds_byte(wr * 64 + fr, fq * 8), boff = lds_byte(wc * 32 + fr, fq * 8);
#define PG8_SA(b, h) (((b) * 2 + (h)) * HTB)
#define PG8_SB(b, h) ((4 + (b) * 2 + (h)) * HTB)
#define PG8_STAGE(bufoff, gbase, voff) do { _Pragma("unroll") for (int _i = 0; _i < 2; ++_i) \
        __builtin_amdgcn_global_load_lds((const unsigned*)((const char*)(gbase) + (voff)[_i]), (LAS unsigned*)(lds + (bufoff) + ldsw + _i * 8192), 16, 0, 0); } while (0)
#define PG8_LDA(dst, b, h) do { _Pragma("unroll") for (int m = 0; m < 4; ++m) _Pragma("unroll") for (int k = 0; k < 2; ++k) dst[m][k] = *(const LAS bf16x8*)(lds + PG8_SA(b, h) + aoff + m * 2048 + k * 1024); } while (0)
#define PG8_LDB(dst, b, h) do { _Pragma("unroll") for (int n = 0; n < 2; ++n) _Pragma("unroll") for (int k = 0; k < 2; ++k) dst[n][k] = *(const LAS bf16x8*)(lds + PG8_SB(b, h) + boff + n * 2048 + k * 1024); } while (0)
#define PG8_MMA(ai, bj, At, Bt) do { __builtin_amdgcn_s_setprio(1); _Pragma("unroll") for (int m = 0; m < 4; ++m) _Pragma("unroll") for (int n = 0; n < 2; ++n) _Pragma("unroll") for (int k = 0; k < 2; ++k) \
        acc[ai][bj][m][n] = __builtin_amdgcn_mfma_f32_16x16x32_bf16(Bt[n][k], At[m][k], acc[ai][bj][m][n], 0, 0, 0); __builtin_amdgcn_s_setprio(0); } while (0)
#define PG8_WAIT_V(n) asm volatile("s_waitcnt vmcnt(" #n ")" ::: "memory")
#define PG8_WAIT_L(n) asm volatile("s_waitcnt lgkmcnt(" #n ")" ::: "memory")
#define PG8_BAR __builtin_amdgcn_s_barrier()
#define PG8_SCHED __builtin_amdgcn_sched_barrier(0)
    Unit cur, nxt; int ui = 0;
    if (!S.next(0, cur)) return;
    f32x4 acc[2][2][4][2];
#pragma unroll
    for (int a = 0; a < 2; ++a)
#pragma unroll
        for (int b = 0; b < 2; ++b)
#pragma unroll
            for (int m = 0; m < 4; ++m)
#pragma unroll
                for (int n = 0; n < 2; ++n) acc[a][b][m][n] = (f32x4){0.f, 0.f, 0.f, 0.f};
    bf16x8 At[4][2], B0[2][2], B1[2][2];
    const char* cA = (const char*)g.arena + (size_t)(cur.pm >> 3) * ARENA + (cur.sel ? g.offA1 : g.offA0) + (size_t)(cur.pm & 7) * tstep; const char* cB = (const char*)(cur.sel ? g.B1 : g.B0) + (size_t)cur.pn * tstep;
    PG8_STAGE(PG8_SB(0, 0), cB, voffB); PG8_STAGE(PG8_SB(0, 1), cB + hstep, voffB); PG8_STAGE(PG8_SA(0, 0), cA, voffA); PG8_STAGE(PG8_SA(0, 1), cA + hstep, voffA);
    if (wr == 1) PG8_BAR;
    PG8_WAIT_V(2); PG8_BAR;
    PG8_STAGE(PG8_SB(1, 0), cB + kstep, voffB); PG8_STAGE(PG8_SA(1, 0), cA + kstep, voffA); PG8_STAGE(PG8_SB(1, 1), cB + hstep + kstep, voffB);
    PG8_WAIT_V(6); PG8_BAR;
    for (;;) {
        const bool has_next = S.next(ui + 1, nxt);
        const char* nA = has_next ? (const char*)g.arena + (size_t)(nxt.pm >> 3) * ARENA + (nxt.sel ? g.offA1 : g.offA0) + (size_t)(nxt.pm & 7) * tstep : cA; const char* nB = has_next ? (const char*)(nxt.sel ? g.B1 : g.B0) + (size_t)nxt.pn * tstep : cB;
        for (int t = 0; t < nt; t += 2) {
            const bool last = (t == nt - 2);
            const char* a1 = cA + (size_t)(t + 1) * kstep;
            const char* a2 = last ? nA : cA + (size_t)(t + 2) * kstep; const char* b2 = last ? nB : cB + (size_t)(t + 2) * kstep;
            const char* a3 = a2 + kstep; const char* b3 = b2 + kstep;
            PG8_LDB(B0, 0, 0); PG8_LDB(B1, 0, 1); PG8_SCHED; PG8_LDA(At, 0, 0); PG8_STAGE(PG8_SA(1, 1), a1 + hstep, voffA);
            PG8_WAIT_V(8); PG8_WAIT_L(0); PG8_BAR; PG8_MMA(0, 0, At, B0); PG8_MMA(0, 1, At, B1); PG8_BAR; PG8_SCHED;
            PG8_LDA(At, 0, 1); PG8_STAGE(PG8_SB(0, 0), b2, voffB); PG8_STAGE(PG8_SB(0, 1), b2 + hstep, voffB); PG8_STAGE(PG8_SA(0, 0), a2, voffA);
            PG8_WAIT_V(8); PG8_WAIT_L(0); PG8_BAR; PG8_MMA(1, 0, At, B0); PG8_MMA(1, 1, At, B1); PG8_BAR; PG8_SCHED;
            PG8_LDB(B0, 1, 0); PG8_LDB(B1, 1, 1); PG8_SCHED; PG8_LDA(At, 1, 0); PG8_STAGE(PG8_SA(0, 1), a2 + hstep, voffA);
            PG8_WAIT_V(8); PG8_WAIT_L(0); PG8_BAR; PG8_MMA(0, 0, At, B0); PG8_MMA(0, 1, At, B1); PG8_BAR; PG8_SCHED;
            PG8_LDA(At, 1, 1); PG8_STAGE(PG8_SB(1, 0), b3, voffB); PG8_STAGE(PG8_SB(1, 1), b3 + hstep, voffB); PG8_STAGE(PG8_SA(1, 0), a3, voffA);
            PG8_WAIT_V(8); PG8_WAIT_L(0); PG8_BAR; PG8_MMA(1, 0, At, B0); PG8_MMA(1, 1, At, B1); PG8_BAR; PG8_SCHED;
        }
        if (wr == 0) PG8_BAR;
        E(acc, cur, wr, wc, fr, fq);
        if (!has_next) break;
#pragma unroll
        for (int a = 0; a < 2; ++a)
#pragma unroll
            for (int b = 0; b < 2; ++b)
#pragma unroll
                for (int m = 0; m < 4; ++m)
#pragma unroll
                    for (int n = 0; n < 2; ++n) acc[a][b][m][n] = (f32x4){0.f, 0.f, 0.f, 0.f};
        cur = nxt; cA = nA; cB = nB; ++ui;
        if (wr == 1) PG8_BAR;
    }
    PG8_WAIT_V(0);
    PG8_BAR;
#undef PG8_SA
#undef PG8_SB
#undef PG8_STAGE
#undef PG8_LDA
#undef PG8_LDB
#undef PG8_MMA
#undef PG8_WAIT_V
#undef PG8_WAIT_L
#undef PG8_BAR
#undef PG8_SCHED
}
}

typedef const f32x4 (&AccRef)[2][2][4][2];
#define EPI_ROWS const int rl0 = (u.pm & 7) * 256 + wr * 64 + fr; unsigned char* const ab = arena + (size_t)(u.pm >> 3) * ARENA
struct EpiIn {
    unsigned char* arena; const float *b_glu, *b_gate;
    __device__ __forceinline__ void operator()(AccRef acc, const pg8::Unit& u, int wr, int wc, int fr, int fq) const {
        EPI_ROWS; const int t = u.pn, cw = wc * 32 + fq * 8;
        if (t < 4) {
            bf16_t* U = (bf16_t*)(ab + AO_U); const int cA = 128 * t + cw; f32x4 ba[2], bb[2];
#pragma unroll
            for (int n = 0; n < 2; ++n) { ba[n] = *(const f32x4*)(b_glu + cA + 4 * n); bb[n] = *(const f32x4*)(b_glu + 512 + cA + 4 * n); }
#pragma unroll
            for (int ai = 0; ai < 2; ++ai)
#pragma unroll
                for (int m = 0; m < 4; ++m) { f32x4 r[2];
#pragma unroll
                    for (int n = 0; n < 2; ++n) { const f32x4 a = acc[ai][0][m][n] + ba[n], b = acc[ai][1][m][n] + bb[n];
#pragma unroll
                        for (int j = 0; j < 4; ++j) r[n][j] = a[j] * sigm(b[j]); }
                    *(u32x4*)(U + (size_t)(rl0 + ai * 128 + m * 16) * DC + cA) = pack8(r[0], r[1]); }
        } else if (t < 6) {
            bf16_t* GB = (bf16_t*)(ab + AO_GB); const int c0 = 256 * (t - 4) + cw;
#pragma unroll
            for (int ai = 0; ai < 2; ++ai)
#pragma unroll
                for (int m = 0; m < 4; ++m)
#pragma unroll
                    for (int bj = 0; bj < 2; ++bj) *(u32x4*)(GB + (size_t)(rl0 + ai * 128 + m * 16) * DC + c0 + 128 * bj) = pack8(acc[ai][bj][m][0], acc[ai][bj][m][1]);
        } else if (t < 10) {
            bf16_t* GCV = (bf16_t*)(ab + AO_GCV); const int cA = 128 * (t - 6) + cw;
#pragma unroll
            for (int ai = 0; ai < 2; ++ai)
#pragma unroll
                for (int m = 0; m < 4; ++m)
                    *(u32x4*)(GCV + (size_t)(rl0 + ai * 128 + m * 16) * DC + cA) = pack8(acc[ai][0][m][0] * acc[ai][1][m][0], acc[ai][0][m][1] * acc[ai][1][m][1]);
        } else {
            bf16_t* GATES = (bf16_t*)(ab + AO_GATES); const int c0 = 256 * (t - 10) + cw; f32x4 bv[2][2];
#pragma unroll
            for (int bj = 0; bj < 2; ++bj)
#pragma unroll
                for (int n = 0; n < 2; ++n) bv[bj][n] = *(const f32x4*)(b_gate + c0 + 128 * bj + 4 * n);
#pragma unroll
            for (int ai = 0; ai < 2; ++ai)
#pragma unroll
                for (int m = 0; m < 4; ++m)
#pragma unroll
                    for (int bj = 0; bj < 2; ++bj) { f32x4 r[2];
#pragma unroll
                        for (int n = 0; n < 2; ++n) { const f32x4 a = acc[ai][bj][m][n] + bv[bj][n];
#pragma unroll
                            for (int j = 0; j < 4; ++j) r[n][j] = sigm(a[j]); }
                        *(u32x4*)(GATES + (size_t)(rl0 + ai * 128 + m * 16) * 2048 + c0 + 128 * bj) = pack8(r[0], r[1]); }
        }
    }
};
struct EpiDual {
    unsigned char* arena; const float* b_out;
    __device__ __forceinline__ void operator()(AccRef acc, const pg8::Unit& u, int wr, int wc, int fr, int fq) const {
        EPI_ROWS; const int c0 = 256 * u.pn + wc * 32 + fq * 8;
        bf16_t* T = (bf16_t*)(ab + AO_T); bf16_t* MIX = (bf16_t*)(ab + AO_MIX); const bf16_t* GATES = (const bf16_t*)(ab + AO_GATES);
        if (u.sel == 0) {
            f32x4 bv[2][2];
#pragma unroll
            for (int bj = 0; bj < 2; ++bj)
#pragma unroll
                for (int n = 0; n < 2; ++n) bv[bj][n] = *(const f32x4*)(b_out + c0 + 128 * bj + 4 * n);
#pragma unroll
            for (int ai = 0; ai < 2; ++ai)
#pragma unroll
                for (int m = 0; m < 4; ++m) { const size_t row = (size_t)(rl0 + ai * 128 + m * 16);
#pragma unroll
                    for (int bj = 0; bj < 2; ++bj) { f32x4 g0, g1; unpack8(*(const u32x4*)(GATES + row * 2048 + c0 + 128 * bj), g0, g1);
                        *(u32x4*)(T + row * D + c0 + 128 * bj) = pack8(g0 * (acc[ai][bj][m][0] + bv[bj][0]), g1 * (acc[ai][bj][m][1] + bv[bj][1])); }
                    asm volatile("" ::: "memory"); }
        } else {
#pragma unroll
            for (int ai = 0; ai < 2; ++ai)
#pragma unroll
                for (int m = 0; m < 4; ++m) { const size_t row = (size_t)(rl0 + ai * 128 + m * 16);
#pragma unroll
                    for (int bj = 0; bj < 2; ++bj) { f32x4 g0, g1, t0, t1; unpack8(*(const u32x4*)(GATES + row * 2048 + 1024 + c0 + 128 * bj), g0, g1);
                        unpack8(*(const u32x4*)(T + row * D + c0 + 128 * bj), t0, t1);
                        *(u32x4*)(MIX + row * D + c0 + 128 * bj) = pack8(t0 + g0 * acc[ai][bj][m][0], t1 + g1 * acc[ai][bj][m][1]); }
                    asm volatile("" ::: "memory"); }
        }
    }
};
template <bool FROM_X> struct EpiRes {
    unsigned char* arena; const float* x; const float* gt;
    __device__ __forceinline__ void operator()(AccRef acc, const pg8::Unit& u, int wr, int wc, int fr, int fq) const {
        EPI_ROWS; const int c0 = 256 * u.pn + wc * 32 + fq * 8, b = u.pm >> 3; f32x4 gv[2][2];
        float* xout = (float*)(ab + AO_X1); const float* xin = FROM_X ? x + (size_t)b * SEQ * D : (const float*)xout;
#pragma unroll
        for (int bj = 0; bj < 2; ++bj)
#pragma unroll
            for (int n = 0; n < 2; ++n) gv[bj][n] = *(const f32x4*)(gt + (size_t)b * NMOD + c0 + 128 * bj + 4 * n);
        f32x4 cur[2][2], nxt[2][2];
        { const size_t off = (size_t)rl0 * D + c0;
#pragma unroll
          for (int bj = 0; bj < 2; ++bj)
#pragma unroll
              for (int n = 0; n < 2; ++n) cur[bj][n] = *(const f32x4*)(xin + off + 128 * bj + 4 * n); }
#pragma unroll
        for (int g = 0; g < 8; ++g) { const int ai = g >> 2, m = g & 3;
            if (g < 7) { const size_t offn = (size_t)(rl0 + ((g + 1) >> 2) * 128 + ((g + 1) & 3) * 16) * D + c0;
#pragma unroll
                for (int bj = 0; bj < 2; ++bj)
#pragma unroll
                    for (int n = 0; n < 2; ++n) nxt[bj][n] = *(const f32x4*)(xin + offn + 128 * bj + 4 * n); }
            const size_t off = (size_t)(rl0 + ai * 128 + m * 16) * D + c0;
#pragma unroll
            for (int bj = 0; bj < 2; ++bj)
#pragma unroll
                for (int n = 0; n < 2; ++n) *(f32x4*)(xout + off + 128 * bj + 4 * n) = cur[bj][n] + gv[bj][n] * acc[ai][bj][m][n];
#pragma unroll
            for (int bj = 0; bj < 2; ++bj)
#pragma unroll
                for (int n = 0; n < 2; ++n) cur[bj][n] = nxt[bj][n];
            asm volatile("" ::: "memory"); }
    }
};
struct EpiGU {
    unsigned char* arena;
    __device__ __forceinline__ void operator()(AccRef acc, const pg8::Unit& u, int wr, int wc, int fr, int fq) const {
        EPI_ROWS; const int cA = 128 * u.pn + wc * 32 + fq * 8; bf16_t* ACT = (bf16_t*)(ab + AO_ACT);
#pragma unroll
        for (int ai = 0; ai < 2; ++ai)
#pragma unroll
            for (int m = 0; m < 4; ++m) { f32x4 r[2];
#pragma unroll
                for (int n = 0; n < 2; ++n) { const f32x4 a = acc[ai][0][m][n], b = acc[ai][1][m][n];
#pragma unroll
                    for (int j = 0; j < 4; ++j) r[n][j] = a[j] * sigm(a[j]) * b[j]; }
                *(u32x4*)(ACT + (size_t)(rl0 + ai * 128 + m * 16) * DFF + cA) = pack8(r[0], r[1]); }
    }
};

__device__ __forceinline__ void p0_mod(const Args& a, float* mod, LAS unsigned char* lds, int item, int tid, int lane, int wave) {
    LAS float* cs = (LAS float*)lds; LAS float* red = (LAS float*)(lds + 32768);
    for (int i = tid; i < NB * D; i += 512) { const int b = i >> 10, k = i & 1023; const float v = a.c[i]; cs[k * 8 + b] = v * sigm(v); }
    __syncthreads();
    const int jl = lane & 31, j = item * 32 + jl, kg = wave * 2 + (lane >> 5);
    float s0 = 0.f, s1 = 0.f, s2 = 0.f, s3 = 0.f, s4 = 0.f, s5 = 0.f, s6 = 0.f, s7 = 0.f;
#pragma unroll 16
    for (int kk = 0; kk < 64; ++kk) { const int k = kg * 64 + kk; const float w = a.w_ada[(size_t)k * NMOD + j];
        const f32x4 c0 = *(const LAS f32x4*)(cs + k * 8), c1 = *(const LAS f32x4*)(cs + k * 8 + 4);
        s0 += w * c0[0]; s1 += w * c0[1]; s2 += w * c0[2]; s3 += w * c0[3]; s4 += w * c1[0]; s5 += w * c1[1]; s6 += w * c1[2]; s7 += w * c1[3]; }
    red[(kg * 8 + 0) * 32 + jl] = s0; red[(kg * 8 + 1) * 32 + jl] = s1; red[(kg * 8 + 2) * 32 + jl] = s2; red[(kg * 8 + 3) * 32 + jl] = s3;
    red[(kg * 8 + 4) * 32 + jl] = s4; red[(kg * 8 + 5) * 32 + jl] = s5; red[(kg * 8 + 6) * 32 + jl] = s6; red[(kg * 8 + 7) * 32 + jl] = s7;
    __syncthreads();
    if (tid < 256) { const int b = tid >> 5, jj = tid & 31; float s = 0.f;
#pragma unroll
        for (int g = 0; g < 16; ++g) s += red[(g * 8 + b) * 32 + jj];
        mod[(size_t)b * NMOD + item * 32 + jj] = s + a.b_ada[item * 32 + jj]; }
    __syncthreads();
}
__device__ __forceinline__ void transpose_item(const float* W, int K, int N, bf16_t* WT, int k0, int nsrc0, int rdst0, LAS float* scr, int lane) {
    { float tv[32];
#pragma unroll
      for (int i = 0; i < 32; ++i) { const int kk = 2 * i + (lane >> 5); tv[i] = W[(size_t)(k0 + kk) * N + nsrc0 + (lane & 31)]; }
#pragma unroll
      for (int i = 0; i < 32; ++i) { const int kk = 2 * i + (lane >> 5); scr[kk * 33 + (lane & 31)] = tv[i]; } }
    asm volatile("s_waitcnt lgkmcnt(0)" ::: "memory");
    const int c = lane & 7;
#pragma unroll
    for (int j = 0; j < 4; ++j) { const int n = (lane >> 3) + 8 * j; const LAS float* s = scr + (8 * c) * 33 + n;
        u32x4 o; o.x = cvt_pk_bf16(s[0 * 33], s[1 * 33]); o.y = cvt_pk_bf16(s[2 * 33], s[3 * 33]); o.z = cvt_pk_bf16(s[4 * 33], s[5 * 33]); o.w = cvt_pk_bf16(s[6 * 33], s[7 * 33]);
        *(u32x4*)(WT + (size_t)(rdst0 + n) * K + k0 + 8 * c) = o; }
    asm volatile("s_waitcnt lgkmcnt(0)" ::: "memory");
}
__device__ __forceinline__ void p0_convert(const Args& a, unsigned char* ws, LAS unsigned char* lds, int gw, int NGW, int wave, int lane) {
    LAS float* scr = (LAS float*)(lds + 49152 + wave * 8448);
    constexpr int I_IN = (D / 64) * (DIN / 32), I_A = (DC / 64) * (D / 32), I_B = I_A, I_O = (D / 64) * (D / 32), I_GU = (D / 64) * (NGU / 32), I_DN = (DFF / 64) * (D / 32);
    constexpr int NITEMS = I_IN + I_A + I_B + I_O + I_GU + I_DN;
    for (int it = gw; it < NITEMS; it += NGW) {
        int r = it;
        if (r < I_IN) { const int nblk = DIN / 32, kb = r / nblk, nb = r % nblk; transpose_item(a.w_in, D, DIN, (bf16_t*)(ws + WS_WIN), 64 * kb, map_in(32 * nb), 32 * nb, scr, lane); continue; } r -= I_IN;
        if (r < I_A) { const int nblk = D / 32, kb = r / nblk, nb = r % nblk; transpose_item(a.conf_w_out, DC, D, (bf16_t*)(ws + WS_WA), 64 * kb, 32 * nb, 32 * nb, scr, lane); continue; } r -= I_A;
        if (r < I_B) { const int nblk = D / 32, kb = r / nblk, nb = r % nblk; transpose_item(a.sc_w_out, DC, D, (bf16_t*)(ws + WS_WB), 64 * kb, 32 * nb, 32 * nb, scr, lane); continue; } r -= I_B;
        if (r < I_O) { const int nblk = D / 32, kb = r / nblk, nb = r % nblk; transpose_item(a.w_o, D, D, (bf16_t*)(ws + WS_WO), 64 * kb, 32 * nb, 32 * nb, scr, lane); continue; } r -= I_O;
        if (r < I_GU) { const int nblk = NGU / 32, kb = r / nblk, nb = r % nblk; transpose_item(a.w_gu, D, NGU, (bf16_t*)(ws + WS_WGU), 64 * kb, map_gu(32 * nb), 32 * nb, scr, lane); continue; } r -= I_GU;
        { const int nblk = D / 32, kb = r / nblk, nb = r % nblk; transpose_item(a.w_down, DFF, D, (bf16_t*)(ws + WS_WDN), 64 * kb, 32 * nb, 32 * nb, scr, lane); }
    }
}
__device__ __forceinline__ float sumsq4(const f32x4 (&v)[4]) { float ss = 0.f;
#pragma unroll
    for (int j = 0; j < 4; ++j) ss += (v[j][0] * v[j][0] + v[j][1] * v[j][1]) + (v[j][2] * v[j][2] + v[j][3] * v[j][3]);
    return ss; }
__device__ __forceinline__ int own_row(int i, int wave, int G, int c) { return (G == 256) ? (c & 7) * SEQ + (c >> 3) * 64 + wave * 8 + i : (c * 8 + wave) + i * (G * 8); }
__device__ __forceinline__ int own_cnt(int G) { return (G == 256) ? 8 : (M + G * 8 - 1) / (G * 8); }
__device__ __forceinline__ const float* x1_row(unsigned char* arena, int m) { return (const float*)(arena + (size_t)(m >> 11) * ARENA + AO_X1) + (size_t)(m & (SEQ - 1)) * D; }
__device__ __forceinline__ void rownorm_mod(const float* xg, unsigned char* arena, const float* g, const float* mod, int sh_off, int sc_off, int wave, int G, int lane, int vid) {
    const int cnt = own_cnt(G); int m = own_row(0, wave, G, vid); if (m >= M) return;
    f32x4 cur[4], nxt[4], mul[4], sh[4]; int bcur = -1;
    { const f32x4* xr = (const f32x4*)(xg ? xg + (size_t)m * D : x1_row(arena, m)) + lane;
#pragma unroll
      for (int j = 0; j < 4; ++j) cur[j] = xr[64 * j]; }
    for (int it = 0; it < cnt && m < M; ++it) { const int mn = (it + 1 < cnt) ? own_row(it + 1, wave, G, vid) : M;
        if (mn < M) { const f32x4* xr = (const f32x4*)(xg ? xg + (size_t)mn * D : x1_row(arena, mn)) + lane;
#pragma unroll
            for (int j = 0; j < 4; ++j) nxt[j] = xr[64 * j]; }
        const int b = m >> 11;
        if (b != bcur) { bcur = b;
#pragma unroll
            for (int j = 0; j < 4; ++j) { const int col = 4 * lane + 256 * j; const f32x4 gv = *(const f32x4*)(g + col), sc = *(const f32x4*)(mod + (size_t)b * NMOD + sc_off + col);
                sh[j] = *(const f32x4*)(mod + (size_t)b * NMOD + sh_off + col); mul[j] = gv * (sc + 1.0f); } }
        const float rstd = rsqrtf(wave_sum(sumsq4(cur)) * (1.f / D) + RMS_EPS);
        u32x2* o8 = (u32x2*)((bf16_t*)(arena + (size_t)b * ARENA + AO_A1) + (size_t)(m & (SEQ - 1)) * D) + lane;
#pragma unroll
        for (int j = 0; j < 4; ++j) { const f32x4 o = cur[j] * rstd * mul[j] + sh[j]; u32x2 w; w.x = cvt_pk_bf16(o[0], o[1]); w.y = cvt_pk_bf16(o[2], o[3]); o8[64 * j] = w; }
#pragma unroll
        for (int j = 0; j < 4; ++j) cur[j] = nxt[j];
        m = mn; }
}
__device__ __forceinline__ void final_norm(unsigned char* arena, float* O, const float* g, int wave, int G, int lane, int vid) {
    f32x4 gv[4];
#pragma unroll
    for (int j = 0; j < 4; ++j) gv[j] = *(const f32x4*)(g + 4 * lane + 256 * j);
    const int cnt = own_cnt(G); f32x4 cur[4], nxt[4]; int m = own_row(0, wave, G, vid);
    if (m < M) { const f32x4* xr = (const f32x4*)x1_row(arena, m) + lane;
#pragma unroll
        for (int j = 0; j < 4; ++j) cur[j] = xr[64 * j]; }
    for (int it = 0; it < cnt && m < M; ++it) { const int mn = (it + 1 < cnt) ? own_row(it + 1, wave, G, vid) : M;
        if (mn < M) { const f32x4* xr = (const f32x4*)x1_row(arena, mn) + lane;
#pragma unroll
            for (int j = 0; j < 4; ++j) nxt[j] = xr[64 * j]; }
        const float rstd = rsqrtf(wave_sum(sumsq4(cur)) * (1.f / D) + RMS_EPS);
        f32x4* orow = (f32x4*)(O + (size_t)m * D) + lane;
#pragma unroll
        for (int j = 0; j < 4; ++j) orow[64 * j] = cur[j] * rstd * gv[j];
#pragma unroll
        for (int j = 0; j < 4; ++j) cur[j] = nxt[j];
        m = mn; }
}
__device__ __forceinline__ void p3_conv(const Args& a, unsigned char* arena, LAS unsigned char* lds, int tid, int lane, int wave, int vid) {
    LAS unsigned* buf = (LAS unsigned*)lds; LAS float* red = (LAS float*)(lds + 94 * 1024);
    const int cp = tid & 255, th = tid >> 8, w4 = wave & 3;
    f32x2 w[CONF_K];
#pragma unroll
    for (int k = 0; k < CONF_K; ++k) w[k] = *(const f32x2*)(a.conf_dw_w + k * DC + 2 * cp);
    const f32x2 cb = *(const f32x2*)(a.conf_dw_b + 2 * cp), lg = *(const f32x2*)(a.conf_ln_g + 2 * cp), lb = *(const f32x2*)(a.conf_ln_b + 2 * cp);
    const f32x2 w30 = *(const f32x2*)(a.sc_dw_w + 2 * cp), w31 = *(const f32x2*)(a.sc_dw_w + DC + 2 * cp), w32 = *(const f32x2*)(a.sc_dw_w + 2 * DC + 2 * cp);
    for (int tl = vid; tl < M / 64; tl += gridDim.x) {
        const int tile = (gridDim.x == 256) ? (tl & 7) * 32 + (tl >> 3) : tl;
        const int b = tile >> 5, t0 = (tile & 31) * 64;
        unsigned char* ab = arena + (size_t)b * ARENA;
        const bf16_t* U = (const bf16_t*)(ab + AO_U); const unsigned* GCV = (const unsigned*)(ab + AO_GCV); const unsigned* GBp = (const unsigned*)(ab + AO_GB);
        unsigned* UA = (unsigned*)(ab + AO_UA); unsigned* VB = (unsigned*)(ab + AO_VB);
        __syncthreads();
        { u32x4 sv[12];
#pragma unroll
          for (int i = 0; i < 12; ++i) { const int ch = tid + 512 * i, row = ch >> 6, c16 = ch & 63; sv[i] = (u32x4){0u, 0u, 0u, 0u};
              if (ch < 94 * 64 && (t0 != 0 || row >= 30)) sv[i] = *(const u32x4*)(U + (size_t)(t0 - 30 + row) * DC + c16 * 8); }
#pragma unroll
          for (int i = 0; i < 12; ++i) { const int ch = tid + 512 * i, row = ch >> 6, c16 = ch & 63; if (ch < 94 * 64) *(LAS u32x4*)(lds + row * 1024 + c16 * 16) = sv[i]; } }
        __syncthreads();
#pragma unroll 1
        for (int chunk = 0; chunk < 4; ++chunk) {
            const int tb = t0 + th * 32 + chunk * 8; unsigned gc[10], gbv[8];
            { const bool head = (tb == 0);
              gc[0] = head ? 0u : GCV[(size_t)(tb - 2) * (DC / 2) + cp]; gc[1] = head ? 0u : GCV[(size_t)(tb - 1) * (DC / 2) + cp];
#pragma unroll
              for (int tt = 0; tt < 8; ++tt) { gc[2 + tt] = GCV[(size_t)(tb + tt) * (DC / 2) + cp]; gbv[tt] = GBp[(size_t)(tb + tt) * (DC / 2) + cp]; } }
            float y0[8], y1[8];
#pragma unroll
            for (int tt = 0; tt < 8; ++tt) { const int lt = th * 32 + chunk * 8 + tt; float a0 = cb[0], a1 = cb[1];
#pragma unroll
                for (int k = 0; k < CONF_K; ++k) { const unsigned v = buf[(lt + k) * 256 + cp]; a0 += w[k][0] * bf_lo(v); a1 += w[k][1] * bf_hi(v); }
                y0[tt] = a0; y1[tt] = a1; }
#pragma unroll
            for (int tt = 0; tt < 8; ++tt) { const float sq = wave_sum(y0[tt] + y1[tt]), q = wave_sum(y0[tt] * y0[tt] + y1[tt] * y1[tt]);
                if (lane == 0) { red[((tt * 2 + th) * 4 + w4) * 2 + 0] = sq; red[((tt * 2 + th) * 4 + w4) * 2 + 1] = q; } }
            __syncthreads();
#pragma unroll
            for (int tt = 0; tt < 8; ++tt) { const int lt = th * 32 + chunk * 8 + tt; const LAS float* r = red + (tt * 2 + th) * 8;
                const float S = (r[0] + r[2]) + (r[4] + r[6]), Q = (r[1] + r[3]) + (r[5] + r[7]);
                const float mean = S * (1.f / DC), var = fmaxf(Q * (1.f / DC) - mean * mean, 0.f), rstd = rsqrtf(var + LN_EPS);
                const float z0 = (y0[tt] - mean) * rstd * lg[0] + lb[0], z1 = (y1[tt] - mean) * rstd * lg[1] + lb[1];
                UA[(size_t)(t0 + lt) * (DC / 2) + cp] = cvt_pk_bf16(z0 * sigm(z0), z1 * sigm(z1)); }
#pragma unroll
            for (int tt = 0; tt < 8; ++tt) { const unsigned p2 = gc[tt], p1 = gc[tt + 1], cur = gc[tt + 2], gb = gbv[tt];
                const float r0 = w30[0] * bf_lo(p2) + w31[0] * bf_lo(p1) + w32[0] * bf_lo(cur), r1 = w30[1] * bf_hi(p2) + w31[1] * bf_hi(p1) + w32[1] * bf_hi(cur);
                VB[(size_t)(tb + tt) * (DC / 2) + cp] = cvt_pk_bf16(bf_lo(gb) * r0, bf_hi(gb) * r1); }
            __syncthreads();
        }
    }
}

__global__ void __launch_bounds__(512, 2) mega(Args a) {
    extern __shared__ __attribute__((aligned(16))) unsigned char lds_raw[];
    LAS unsigned char* lds = (LAS unsigned char*)lds_raw;
    const int G = gridDim.x;
#define PHASE_IDS const int tid = opaque_tid(), lane = tid & 63, wave = __builtin_amdgcn_readfirstlane(tid >> 6); (void)tid; (void)lane; (void)wave
    unsigned char* ws = a.ws; float* mod = (float*)(ws + WS_MOD); unsigned char* arena = ws + WS_ARENA;
    volatile LAS unsigned* misc = (volatile LAS unsigned*)(lds + 131072);
    unsigned* ctl = (unsigned*)ws;
#define VID ((int)misc[2])
#define GRID_BARRIER(idx) do { asm volatile("s_waitcnt vmcnt(0) lgkmcnt(0)" ::: "memory"); __syncthreads(); \
        if (threadIdx.x == 0) { unsigned* bw = ctl + 1024 + 64 * (idx); __builtin_amdgcn_fence(__ATOMIC_RELEASE, "agent"); asm volatile("s_waitcnt vmcnt(0)" ::: "memory"); \
            __hip_atomic_fetch_add(bw, 1u, __ATOMIC_RELAXED, __HIP_MEMORY_SCOPE_AGENT); \
            while (__hip_atomic_load(bw, __ATOMIC_RELAXED, __HIP_MEMORY_SCOPE_AGENT) < gridDim.x) __builtin_amdgcn_s_sleep(1); \
            __builtin_amdgcn_fence(__ATOMIC_ACQUIRE, "agent"); asm volatile("s_waitcnt vmcnt(0)" ::: "memory"); } \
        __syncthreads(); asm volatile("" ::: "memory"); } while (0)
#define SEAM(k) do { if (misc[3] != 0u) { asm volatile("s_waitcnt vmcnt(0) lgkmcnt(0)" ::: "memory"); __syncthreads(); \
            if (threadIdx.x == 0) { unsigned* bw = ctl + 2048 + 64 * misc[0] + (k); __hip_atomic_fetch_add(bw, 1u, __ATOMIC_RELAXED, __HIP_MEMORY_SCOPE_AGENT); \
                while (__hip_atomic_load(bw, __ATOMIC_RELAXED, __HIP_MEMORY_SCOPE_AGENT) < 32u) __builtin_amdgcn_s_sleep(1); \
                __builtin_amdgcn_fence(__ATOMIC_ACQUIRE, "agent"); asm volatile("s_waitcnt vmcnt(0)" ::: "memory"); } \
            __syncthreads(); asm volatile("" ::: "memory"); } else GRID_BARRIER(k); } while (0)

    if (threadIdx.x == 0) { const unsigned xcc = (unsigned)__builtin_amdgcn_s_getreg((3 << 11) | 20) & 0xFu;
        misc[0] = xcc; misc[1] = __hip_atomic_fetch_add(ctl + 64 * xcc, 1u, __ATOMIC_RELAXED, __HIP_MEMORY_SCOPE_AGENT); misc[2] = blockIdx.x; misc[3] = 0u; }

    { PHASE_IDS; const int gw = blockIdx.x * 8 + wave, NGW = G * 8;
        if (G >= 256) { if (blockIdx.x < 192) p0_mod(a, mod, lds, blockIdx.x, tid, lane, wave); }
        else { for (int it = blockIdx.x; it < 192; it += G) p0_mod(a, mod, lds, it, tid, lane, wave); }
        p0_convert(a, ws, lds, gw, NGW, wave, lane);
    }
    asm volatile("s_waitcnt vmcnt(0) lgkmcnt(0)" ::: "memory"); cg::this_grid().sync();
    if (threadIdx.x == 0) { __builtin_amdgcn_fence(__ATOMIC_ACQUIRE, "agent"); asm volatile("s_waitcnt vmcnt(0)" ::: "memory");
        bool even = (G == 256);
        for (int j = 0; j < 16; ++j) { const unsigned cnt = __hip_atomic_load(ctl + 64 * j, __ATOMIC_RELAXED, __HIP_MEMORY_SCOPE_AGENT); if (cnt != (j < 8 ? 32u : 0u)) even = false; }
        if (even) { misc[2] = misc[1] * 8u + misc[0]; misc[3] = 1u; } }
    __syncthreads();

    { PHASE_IDS; rownorm_mod(a.x, arena, a.norm1_g, mod, MO_SH1, MO_SC1, wave, G, lane, VID); }
    SEAM(1);
    { pg8::Gemm g{arena, (unsigned)AO_A1, 0u, (const bf16_t*)(ws + WS_WIN), nullptr, D}; pg8::Order S; S.init(M, DIN, G, VID, 0);
      EpiIn E{arena, a.b_glu, a.b_gate}; pg8::gemm_phase(lds, g, S, E); }
    SEAM(2);
    { PHASE_IDS; p3_conv(a, arena, lds, tid, lane, wave, VID); }
    SEAM(3);
    { pg8::Gemm g{arena, (unsigned)AO_UA, (unsigned)AO_VB, (const bf16_t*)(ws + WS_WA), (const bf16_t*)(ws + WS_WB), DC}; pg8::Order S; S.init(M, D, G, VID, 1);
      EpiDual E{arena, a.conf_b_out}; pg8::gemm_phase(lds, g, S, E); }
    SEAM(4);
    { pg8::Gemm g{arena, (unsigned)AO_MIX, 0u, (const bf16_t*)(ws + WS_WO), nullptr, D}; pg8::Order S; S.init(M, D, G, VID, 0);
      EpiRes<true> E{arena, a.x, mod + MO_GT1}; pg8::gemm_phase(lds, g, S, E); }
    SEAM(5);
    { PHASE_IDS; rownorm_mod(nullptr, arena, a.norm2_g, mod, MO_SH2, MO_SC2, wave, G, lane, VID); }
    SEAM(6);
    { pg8::Gemm g{arena, (unsigned)AO_A1, 0u, (const bf16_t*)(ws + WS_WGU), nullptr, D}; pg8::Order S; S.init(M, NGU, G, VID, 0);
      EpiGU E{arena}; pg8::gemm_phase(lds, g, S, E); }
    SEAM(7);
    { pg8::Gemm g{arena, (unsigned)AO_ACT, 0u, (const bf16_t*)(ws + WS_WDN), nullptr, DFF}; pg8::Order S; S.init(M, D, G, VID, 0);
      EpiRes<false> E{arena, nullptr, mod + MO_GT2}; pg8::gemm_phase(lds, g, S, E); }
    SEAM(8);
    { PHASE_IDS; final_norm(arena, a.out, a.final_g, wave, G, lane, VID); }
#undef SEAM
#undef GRID_BARRIER
#undef VID
#undef PHASE_IDS
}

extern "C" void kernel_launch(void* const* d_in, const int* in_sizes, int n_in, void* d_out, int out_size, void* d_ws, size_t ws_size, hipStream_t stream) {
    static int grid = 0;
    if (grid == 0) {
        if (n_in != 21 || out_size != M * D || ws_size < WS_END) { fprintf(stderr, "kernel_launch: unexpected shapes (n_in %d out %d ws %zu)\n", n_in, out_size, ws_size); grid = -1; return; }
        int dev = 0, cus = 0, per_cu = 0;
        (void)hipGetDevice(&dev); (void)hipDeviceGetAttribute(&cus, hipDeviceAttributeMultiprocessorCount, dev);
        if (hipFuncSetAttribute((const void*)mega, hipFuncAttributeMaxDynamicSharedMemorySize, LDS_BYTES) != hipSuccess) { fprintf(stderr, "kernel_launch: hipFuncSetAttribute failed\n"); grid = -1; return; }
        if (hipOccupancyMaxActiveBlocksPerMultiprocessor(&per_cu, (const void*)mega, 512, LDS_BYTES) != hipSuccess || per_cu < 1) { fprintf(stderr, "kernel_launch: occupancy query gave %d\n", per_cu); per_cu = 1; }
        (void)hipGetLastError();
        grid = cus * per_cu;
    }
    if (grid < 0) return;
    Args a{};
    const float** ap = (const float**)&a;
    for (int i = 0; i < 21; ++i) ap[i] = (const float*)d_in[i];
    a.out = (float*)d_out; a.ws = (unsigned char*)d_ws; a.ph_lo = 0; a.ph_hi = 10;
    (void)hipMemsetAsync(d_ws, 0, 16384, stream);
    void* args[] = {&a};
    hipError_t e = hipLaunchCooperativeKernel((const void*)mega, dim3(grid), dim3(512), args, LDS_BYTES, stream);
    if (e != hipSuccess) fprintf(stderr, "cooperative launch failed: %s (grid %d)\n", hipGetErrorString(e), grid);
}
```

```cpp
#include <hip/hip_runtime.h>
#include <hip/hip_cooperative_groups.h>
#include <cstdio>
#include <cstdint>
namespace cg = cooperative_groups;


#define LAS __attribute__((address_space(3)))
typedef unsigned short bf16_t;
typedef short bf16x8 __attribute__((ext_vector_type(8)));
typedef float f32x4 __attribute__((ext_vector_type(4)));
typedef float f32x2 __attribute__((ext_vector_type(2)));
typedef unsigned u32x4 __attribute__((ext_vector_type(4)));
typedef unsigned u32x2 __attribute__((ext_vector_type(2)));

constexpr int NB = 8, SEQ = 2048, D = 1024, M = NB * SEQ, DC = 512, DIN = 4608, DFF = 2816, NGU = 2 * DFF, NMOD = 6 * D;
constexpr int CONF_K = 31;
constexpr float RMS_EPS = 1e-6f, LN_EPS = 1e-5f;
constexpr int MO_SH1 = 0, MO_SC1 = D, MO_GT1 = 2 * D, MO_SH2 = 3 * D, MO_SC2 = 4 * D, MO_GT2 = 5 * D;

constexpr size_t MiB = 1u << 20;
constexpr size_t WS_MOD = 1 * MiB;
constexpr size_t WS_XCH = 2 * MiB;
constexpr size_t WS_WIN = 8 * MiB;
constexpr size_t WS_WA = 17 * MiB;
constexpr size_t WS_WB = 18 * MiB;
constexpr size_t WS_WO = 19 * MiB;
constexpr size_t WS_WGU = 21 * MiB;
constexpr size_t WS_WDN = 32 * MiB;
constexpr size_t WS_ARENA = 40 * MiB, ARENA = 24 * MiB;
constexpr size_t AO_A1 = 0;
constexpr size_t AO_UA = 0, AO_VB = 2 * MiB;
constexpr size_t AO_U = 4 * MiB, AO_GCV = 6 * MiB, AO_GB = 8 * MiB;
constexpr size_t AO_T = 4 * MiB;
constexpr size_t AO_MIX = 10 * MiB;
constexpr size_t AO_ACT = 4 * MiB;
constexpr size_t AO_GATES = 15 * MiB;
constexpr size_t AO_X1 = 15 * MiB;
constexpr size_t AO_MODX = 23 * MiB;
constexpr size_t WS_MODP = 3 * MiB;
constexpr int MSTR = (int)(ARENA / 4);
constexpr size_t WS_END = WS_ARENA + 8 * ARENA;
constexpr int LDS_BYTES = 131072 + 2048;

struct Args {
    const float *x, *c, *w_ada, *b_ada, *norm1_g, *w_in, *b_glu, *conf_dw_w, *conf_dw_b, *conf_ln_g, *conf_ln_b, *conf_w_out, *conf_b_out,
        *sc_dw_w, *sc_w_out, *b_gate, *w_o, *norm2_g, *w_gu, *w_down, *final_g;
    float* out; unsigned char* ws; int ph_lo, ph_hi;
};

__device__ __forceinline__ float bf_lo(unsigned v) { return __uint_as_float(v << 16); }
__device__ __forceinline__ float bf_hi(unsigned v) { return __uint_as_float(v & 0xffff0000u); }
__device__ __forceinline__ float bf2f(bf16_t v) { return __uint_as_float(((unsigned)v) << 16); }
typedef __bf16 bf16x2_t __attribute__((ext_vector_type(2)));
__device__ __forceinline__ unsigned cvt_pk_bf16(float lo, float hi) { const f32x2 v = {lo, hi}; const bf16x2_t b = __builtin_convertvector(v, bf16x2_t); return __builtin_bit_cast(unsigned, b); }
__device__ __forceinline__ bf16_t f2bf(float f) { return (bf16_t)(cvt_pk_bf16(f, 0.f) & 0xffffu); }
__device__ __forceinline__ u32x4 pack8(const f32x4 a, const f32x4 b) { u32x4 w; w.x = cvt_pk_bf16(a[0], a[1]); w.y = cvt_pk_bf16(a[2], a[3]); w.z = cvt_pk_bf16(b[0], b[1]); w.w = cvt_pk_bf16(b[2], b[3]); return w; }
__device__ __forceinline__ void unpack8(const u32x4 w, f32x4& a, f32x4& b) { a[0] = bf_lo(w.x); a[1] = bf_hi(w.x); a[2] = bf_lo(w.y); a[3] = bf_hi(w.y); b[0] = bf_lo(w.z); b[1] = bf_hi(w.z); b[2] = bf_lo(w.w); b[3] = bf_hi(w.w); }
__device__ __forceinline__ float sigm(float x) { return __builtin_amdgcn_rcpf(1.0f + __builtin_amdgcn_exp2f(-1.4426950408889634f * x)); }
__device__ __forceinline__ int opaque_tid() { int t = threadIdx.x; asm volatile("" : "+v"(t)); return t; }
__device__ __forceinline__ float wave_sum(float v) {
#pragma unroll
    for (int o = 1; o < 64; o <<= 1) v += __shfl_xor(v, o);
    return v;
}
__device__ __forceinline__ int map_in(int r) {
    const int t = r >> 8, j = r & 255, h = j >> 7, jj = j & 127;
    if (t < 4) return h * 512 + 128 * t + jj;
    if (t < 6) return 1024 + 256 * (t - 4) + j;
    if (t < 10) return (h ? 2048 : 1536) + 128 * (t - 6) + jj;
    return 2560 + 256 * (t - 10) + j;
}
__device__ __forceinline__ int map_gu(int r) { const int t = r >> 8, j = r & 255, h = j >> 7, jj = j & 127; return h * DFF + 128 * t + jj; }

namespace pg8 {
constexpr int BM = 256, BK = 64, HALF = 128, HTB = HALF * BK * 2, STAGE_BYTES = 8 * HTB, NXCD = 8, WGM = 8;
__device__ __forceinline__ int lds_byte(int r, int c) { const int st = (r >> 4) * 2 + (c >> 5), rr = r & 15, cc = c & 31, ob = rr * 64 + cc * 2; return st * 1024 + (ob ^ (((ob >> 9) & 1) << 5)); }
__device__ __forceinline__ void stage_rc(int b, int& R, int& C) { const int st = b / 1024, sb = b % 1024, swz = sb ^ (((sb >> 9) & 1) << 5); R = (st >> 1) * 16 + swz / 64; C = (st & 1) * 32 + (swz % 64) / 2; }
__device__ __forceinline__ int perm32(int rho) { const int n = rho >> 4, i = rho & 15; return 8 * (i >> 2) + 4 * n + (i & 3); }

struct Unit { int pm, pn, sel; };
struct Gemm { const unsigned char* arena; unsigned offA0, offA1; const bf16_t *B0, *B1; int K; };

struct Order {
    int nM, nN, nwg, G, c, dual;
    __device__ void init(int M_, int N_, int G_, int c_, int dual_) { nM = M_ / BM; nN = N_ / BM; nwg = nM * nN; G = G_; c = c_; dual = dual_; }
    __device__ bool next(int i, Unit& u) const {
        const int ii = dual ? (i >> 1) : i;
        const long L = (long)ii * G + c; if (L >= nwg) return false;
        int wgid = (int)L; { const int q = nwg / NXCD, r = nwg % NXCD, xcd = wgid % NXCD, off = wgid / NXCD; wgid = (xcd < r ? xcd * (q + 1) : r * (q + 1) + (xcd - r) * q) + off; }
        const int nig = WGM * nN, gid = wgid / nig, fm = gid * WGM, gsz = (nM - fm) < WGM ? (nM - fm) : WGM;
        u.pm = fm + ((wgid % nig) % gsz); u.pn = (wgid % nig) / gsz; u.sel = dual ? (i & 1) : 0; return true;
    }
};

template <class Epi>
__device__ __forceinline__ void gemm_phase(LAS unsigned char* lds, const Gemm g, const Order& S, const Epi& E) {
    const int tid = opaque_tid(), wid = __builtin_amdgcn_readfirstlane(tid >> 6), lane = tid & 63, wr = wid >> 2, wc = wid & 3, fr = lane & 15, fq = lane >> 4;
    const int K = g.K, nt = K / BK;
    unsigned voffA[2], voffB[2];
#pragma unroll
    for (int i = 0; i < 2; ++i) { int R, C; stage_rc(tid * 16 + i * 8192, R, C); const int Rb = (R & ~31) + perm32(R & 31);
        voffA[i] = (unsigned)(R * K + C) * 2u; voffB[i] = (unsigned)(Rb * K + C) * 2u; }
    const size_t kstep = (size_t)(BK * 2);
    const size_t hstep = (size_t)HALF * K * 2;
    const size_t tstep = 2 * hstep;
    const unsigned ldsw = (unsigned)wid * 1024u;
    const int aoff = lds_byte(wr * 64 + fr, fq * 8), boff = lds_byte(wc * 32 + fr, fq * 8);
#define PG8_SA(b, h) (((b) * 2 + (h)) * HTB)
#define PG8_SB(b, h) ((4 + (b) * 2 + (h)) * HTB)
#define PG8_STAGE(bufoff, gbase, voff) do { _Pragma("unroll") for (int _i = 0; _i < 2; ++_i) \
        __builtin_amdgcn_global_load_lds((const unsigned*)((const char*)(gbase) + (voff)[_i]), (LAS unsigned*)(lds + (bufoff) + ldsw + _i * 8192), 16, 0, 0); } while (0)
#define PG8_LDA(dst, b, h) do { _Pragma("unroll") for (int m = 0; m < 4; ++m) _Pragma("unroll") for (int k = 0; k < 2; ++k) dst[m][k] = *(const LAS bf16x8*)(lds + PG8_SA(b, h) + aoff + m * 2048 + k * 1024); } while (0)
#define PG8_LDB(dst, b, h) do { _Pragma("unroll") for (int n = 0; n < 2; ++n) _Pragma("unroll") for (int k = 0; k < 2; ++k) dst[n][k] = *(const LAS bf16x8*)(lds + PG8_SB(b, h) + boff + n * 2048 + k * 1024); } while (0)
#define PG8_MMA(ai, bj, At, Bt) do { __builtin_amdgcn_s_setprio(1); _Pragma("unroll") for (int m = 0; m < 4; ++m) _Pragma("unroll") for (int n = 0; n < 2; ++n) _Pragma("unroll") for (int k = 0; k < 2; ++k) \
        acc[ai][bj][m][n] = __builtin_amdgcn_mfma_f32_16x16x32_bf16(Bt[n][k], At[m][k], acc[ai][bj][m][n], 0, 0, 0); __builtin_amdgcn_s_setprio(0); } while (0)
#define PG8_WAIT_V(n) asm volatile("s_waitcnt vmcnt(" #n ")" ::: "memory")
#define PG8_WAIT_L(n) asm volatile("s_waitcnt lgkmcnt(" #n ")" ::: "memory")
#define PG8_BAR __builtin_amdgcn_s_barrier()
#define PG8_SCHED __builtin_amdgcn_sched_barrier(0)
    Unit cur, nxt; int ui = 0;
    if (!S.next(0, cur)) return;
    f32x4 acc[2][2][4][2];
#pragma unroll
    for (int a = 0; a < 2; ++a)
#pragma unroll
        for (int b = 0; b < 2; ++b)
#pragma unroll
            for (int m = 0; m < 4; ++m)
#pragma unroll
                for (int n = 0; n < 2; ++n) acc[a][b][m][n] = (f32x4){0.f, 0.f, 0.f, 0.f};
    bf16x8 At[4][2], B0[2][2], B1[2][2];
    const char* cA = (const char*)g.arena + (size_t)(cur.pm >> 3) * ARENA + (cur.sel ? g.offA1 : g.offA0) + (size_t)(cur.pm & 7) * tstep; const char* cB = (const char*)(cur.sel ? g.B1 : g.B0) + (size_t)cur.pn * tstep;
    PG8_STAGE(PG8_SB(0, 0), cB, voffB); PG8_STAGE(PG8_SB(0, 1), cB + hstep, voffB); PG8_STAGE(PG8_SA(0, 0), cA, voffA); PG8_STAGE(PG8_SA(0, 1), cA + hstep, voffA);
    if (wr == 1) PG8_BAR;
    PG8_WAIT_V(2); PG8_BAR;
    PG8_STAGE(PG8_SB(1, 0), cB + kstep, voffB); PG8_STAGE(PG8_SA(1, 0), cA + kstep, voffA); PG8_STAGE(PG8_SB(1, 1), cB + hstep + kstep, voffB);
    PG8_WAIT_V(6); PG8_BAR;
    for (;;) {
        const bool has_next = S.next(ui + 1, nxt);
        const char* nA = has_next ? (const char*)g.arena + (size_t)(nxt.pm >> 3) * ARENA + (nxt.sel ? g.offA1 : g.offA0) + (size_t)(nxt.pm & 7) * tstep : cA; const char* nB = has_next ? (const char*)(nxt.sel ? g.B1 : g.B0) + (size_t)nxt.pn * tstep : cB;
        for (int t = 0; t < nt; t += 2) {
            const bool last = (t == nt - 2);
            const char* a1 = cA + (size_t)(t + 1) * kstep;
            const char* a2 = last ? nA : cA + (size_t)(t + 2) * kstep; const char* b2 = last ? nB : cB + (size_t)(t + 2) * kstep;
            const char* a3 = a2 + kstep; const char* b3 = b2 + kstep;
            PG8_LDB(B0, 0, 0); PG8_LDB(B1, 0, 1); PG8_SCHED; PG8_LDA(At, 0, 0); PG8_STAGE(PG8_SA(1, 1), a1 + hstep, voffA);
            PG8_WAIT_V(8); PG8_WAIT_L(0); PG8_BAR; PG8_MMA(0, 0, At, B0); PG8_MMA(0, 1, At, B1); PG8_BAR; PG8_SCHED;
            PG8_LDA(At, 0, 1); PG8_STAGE(PG8_SB(0, 0), b2, voffB); PG8_STAGE(PG8_SB(0, 1), b2 + hstep, voffB); PG8_STAGE(PG8_SA(0, 0), a2, voffA);
            PG8_WAIT_V(8); PG8_WAIT_L(0); PG8_BAR; PG8_MMA(1, 0, At, B0); PG8_MMA(1, 1, At, B1); PG8_BAR; PG8_SCHED;
            PG8_LDB(B0, 1, 0); PG8_LDB(B1, 1, 1); PG8_SCHED; PG8_LDA(At, 1, 0); PG8_STAGE(PG8_SA(0, 1), a2 + hstep, voffA);
            PG8_WAIT_V(8); PG8_WAIT_L(0); PG8_BAR; PG8_MMA(0, 0, At, B0); PG8_MMA(0, 1, At, B1); PG8_BAR; PG8_SCHED;
            PG8_LDA(At, 1, 1); PG8_STAGE(PG8_SB(1, 0), b3, voffB); PG8_STAGE(PG8_SB(1, 1), b3 + hstep, voffB); PG8_STAGE(PG8_SA(1, 0), a3, voffA);
            PG8_WAIT_V(8); PG8_WAIT_L(0); PG8_BAR; PG8_MMA(1, 0, At, B0); PG8_MMA(1, 1, At, B1); PG8_BAR; PG8_SCHED;
        }
        if (wr == 0) PG8_BAR;
        if constexpr (Epi::TRANSFORM) { if (cur.sel == 0) E.transform(acc, cur, wr, wc, fr, fq); else E(acc, cur, wr, wc, fr, fq); }
        else if constexpr (!Epi::AFTER_DRAIN) E(acc, cur, wr, wc, fr, fq);
        if (!has_next) break;
        if (!(Epi::TRANSFORM && cur.sel == 0))
#pragma unroll
        for (int a = 0; a < 2; ++a)
#pragma unroll
            for (int b = 0; b < 2; ++b)
#pragma unroll
                for (int m = 0; m < 4; ++m)
#pragma unroll
                    for (int n = 0; n < 2; ++n) acc[a][b][m][n] = (f32x4){0.f, 0.f, 0.f, 0.f};
        cur = nxt; cA = nA; cB = nB; ++ui;
        if (wr == 1) PG8_BAR;
    }
    PG8_WAIT_V(0);
    PG8_BAR;
    if constexpr (Epi::AFTER_DRAIN) E.fused(acc, cur, wr, wc, fr, fq, lds, wid, lane);
#undef PG8_SA
#undef PG8_SB
#undef PG8_STAGE
#undef PG8_LDA
#undef PG8_LDB
#undef PG8_MMA
#undef PG8_WAIT_V
#undef PG8_WAIT_L
#undef PG8_BAR
#undef PG8_SCHED
}
}

typedef const f32x4 (&AccRef)[2][2][4][2];
#define EPI_ROWS const int rl0 = (u.pm & 7) * 256 + wr * 64 + fr; unsigned char* const ab = arena + (size_t)(u.pm >> 3) * ARENA
struct EpiIn {
    static constexpr bool AFTER_DRAIN = false, TRANSFORM = false;
    unsigned char* arena; const float *b_glu, *b_gate;
    __device__ __forceinline__ void operator()(AccRef acc, const pg8::Unit& u, int wr, int wc, int fr, int fq) const {
        EPI_ROWS; const int t = u.pn, cw = wc * 32 + fq * 8;
        if (t < 4) {
            bf16_t* U = (bf16_t*)(ab + AO_U); const int cA = 128 * t + cw; f32x4 ba[2], bb[2];
#pragma unroll
            for (int n = 0; n < 2; ++n) { ba[n] = *(const f32x4*)(b_glu + cA + 4 * n); bb[n] = *(const f32x4*)(b_glu + 512 + cA + 4 * n); }
#pragma unroll
            for (int ai = 0; ai < 2; ++ai)
#pragma unroll
                for (int m = 0; m < 4; ++m) { f32x4 r[2];
#pragma unroll
                    for (int n = 0; n < 2; ++n) { const f32x4 a = acc[ai][0][m][n] + ba[n], b = acc[ai][1][m][n] + bb[n];
#pragma unroll
                        for (int j = 0; j < 4; ++j) r[n][j] = a[j] * sigm(b[j]); }
                    *(u32x4*)(U + (size_t)(rl0 + ai * 128 + m * 16) * DC + cA) = pack8(r[0], r[1]); }
        } else if (t < 6) {
            bf16_t* GB = (bf16_t*)(ab + AO_GB); const int c0 = 256 * (t - 4) + cw;
#pragma unroll
            for (int ai = 0; ai < 2; ++ai)
#pragma unroll
                for (int m = 0; m < 4; ++m)
#pragma unroll
                    for (int bj = 0; bj < 2; ++bj) *(u32x4*)(GB + (size_t)(rl0 + ai * 128 + m * 16) * DC + c0 + 128 * bj) = pack8(acc[ai][bj][m][0], acc[ai][bj][m][1]);
        } else if (t < 10) {
            bf16_t* GCV = (bf16_t*)(ab + AO_GCV); const int cA = 128 * (t - 6) + cw;
#pragma unroll
            for (int ai = 0; ai < 2; ++ai)
#pragma unroll
                for (int m = 0; m < 4; ++m)
                    *(u32x4*)(GCV + (size_t)(rl0 + ai * 128 + m * 16) * DC + cA) = pack8(acc[ai][0][m][0] * acc[ai][1][m][0], acc[ai][0][m][1] * acc[ai][1][m][1]);
        } else {
            unsigned char* GATES = ab + AO_GATES; const int c0 = 256 * (t - 10) + cw, cg16 = 256 * (t - 10) + wc * 64 + fq * 16; f32x4 bv[2][2]; const float qmin = (t >= 14) ? 1.0f : 0.0f;
#pragma unroll
            for (int bj = 0; bj < 2; ++bj)
#pragma unroll
                for (int n = 0; n < 2; ++n) bv[bj][n] = *(const f32x4*)(b_gate + c0 + 128 * bj + 4 * n);
#pragma unroll
            for (int ai = 0; ai < 2; ++ai)
#pragma unroll
                for (int m = 0; m < 4; ++m)
                    { u32x4 w4;
#pragma unroll
                      for (int bj = 0; bj < 2; ++bj)
#pragma unroll
                        for (int n = 0; n < 2; ++n) { const f32x4 a = acc[ai][bj][m][n] + bv[bj][n]; unsigned q = 0u;
#pragma unroll
                            for (int j = 0; j < 4; ++j) q = __builtin_amdgcn_cvt_pk_u8_f32(fmaxf(255.0f * sigm(a[j]), qmin), j, q);
                            w4[bj * 2 + n] = q; }
                      *(u32x4*)(GATES + (size_t)(rl0 + ai * 128 + m * 16) * 2048 + cg16) = w4; }
        }
    }
};
struct EpiDual {
    static constexpr bool AFTER_DRAIN = false, TRANSFORM = true;
    unsigned char* arena; const float* b_out;
    __device__ __forceinline__ void transform(f32x4 (&acc)[2][2][4][2], const pg8::Unit& u, int wr, int wc, int fr, int fq) const {
        EPI_ROWS; const int c0 = 256 * u.pn + wc * 32 + fq * 8, cg16 = 256 * u.pn + wc * 64 + fq * 16; const unsigned char* GA = ab + AO_GATES; f32x4 bv[2][2];
#pragma unroll
        for (int bj = 0; bj < 2; ++bj)
#pragma unroll
            for (int n = 0; n < 2; ++n) bv[bj][n] = *(const f32x4*)(b_out + c0 + 128 * bj + 4 * n);
        u32x4 ac = *(const u32x4*)(GA + (size_t)rl0 * 2048 + cg16), bc = *(const u32x4*)(GA + (size_t)rl0 * 2048 + 1024 + cg16), an, bn;
#pragma unroll
        for (int g = 0; g < 8; ++g) { const int ai = g >> 2, m = g & 3;
            if (g < 7) { const size_t rown = (size_t)(rl0 + ((g + 1) >> 2) * 128 + ((g + 1) & 3) * 16);
                an = *(const u32x4*)(GA + rown * 2048 + cg16); bn = *(const u32x4*)(GA + rown * 2048 + 1024 + cg16); }
#pragma unroll
            for (int bj = 0; bj < 2; ++bj)
#pragma unroll
                for (int n = 0; n < 2; ++n)
#pragma unroll
                    for (int j = 0; j < 4; ++j) {
                        const float r = (float)((ac[bj * 2 + n] >> (8 * j)) & 0xffu) * __builtin_amdgcn_rcpf((float)((bc[bj * 2 + n] >> (8 * j)) & 0xffu));
                        acc[ai][bj][m][n][j] = (acc[ai][bj][m][n][j] + bv[bj][n][j]) * r; }
            ac = an; bc = bn;
            asm volatile("" ::: "memory"); }
    }
    __device__ __forceinline__ void operator()(AccRef acc, const pg8::Unit& u, int wr, int wc, int fr, int fq) const {
        EPI_ROWS; const int c0 = 256 * u.pn + wc * 32 + fq * 8, cg16 = 256 * u.pn + wc * 64 + fq * 16; bf16_t* MIX = (bf16_t*)(ab + AO_MIX); const unsigned char* GB = ab + AO_GATES + 1024;
        u32x4 bc = *(const u32x4*)(GB + (size_t)rl0 * 2048 + cg16), bn;
#pragma unroll
        for (int g = 0; g < 8; ++g) { const int ai = g >> 2, m = g & 3;
            if (g < 7) { const size_t rown = (size_t)(rl0 + ((g + 1) >> 2) * 128 + ((g + 1) & 3) * 16); bn = *(const u32x4*)(GB + rown * 2048 + cg16); }
            const size_t row = (size_t)(rl0 + ai * 128 + m * 16);
#pragma unroll
            for (int bj = 0; bj < 2; ++bj) { f32x4 g0, g1;
#pragma unroll
                for (int j = 0; j < 4; ++j) { g0[j] = (float)((bc[bj * 2] >> (8 * j)) & 0xffu) * (1.0f / 255.0f); g1[j] = (float)((bc[bj * 2 + 1] >> (8 * j)) & 0xffu) * (1.0f / 255.0f); }
                *(u32x4*)(MIX + row * D + c0 + 128 * bj) = pack8(acc[ai][bj][m][0] * g0, acc[ai][bj][m][1] * g1); }
            bc = bn;
            asm volatile("" ::: "memory"); }
    }
};
template <bool FROM_X> struct EpiRes {
    static constexpr bool AFTER_DRAIN = false, TRANSFORM = false;
    unsigned char* arena; const float* x; const float* gt;
    __device__ __forceinline__ void operator()(AccRef acc, const pg8::Unit& u, int wr, int wc, int fr, int fq) const {
        EPI_ROWS; const int c0 = 256 * u.pn + wc * 32 + fq * 8, b = u.pm >> 3; f32x4 gv[2][2];
        float* xout = (float*)(ab + AO_X1); const float* xin = FROM_X ? x + (size_t)b * SEQ * D : (const float*)xout;
#pragma unroll
        for (int bj = 0; bj < 2; ++bj)
#pragma unroll
            for (int n = 0; n < 2; ++n) gv[bj][n] = *(const f32x4*)(gt + (size_t)b * MSTR + c0 + 128 * bj + 4 * n);
        f32x4 cur[2][2], nxt[2][2];
        { const size_t off = (size_t)rl0 * D + c0;
#pragma unroll
          for (int bj = 0; bj < 2; ++bj)
#pragma unroll
              for (int n = 0; n < 2; ++n) cur[bj][n] = *(const f32x4*)(xin + off + 128 * bj + 4 * n); }
#pragma unroll
        for (int g = 0; g < 8; ++g) { const int ai = g >> 2, m = g & 3;
            if (g < 7) { const size_t offn = (size_t)(rl0 + ((g + 1) >> 2) * 128 + ((g + 1) & 3) * 16) * D + c0;
#pragma unroll
                for (int bj = 0; bj < 2; ++bj)
#pragma unroll
                    for (int n = 0; n < 2; ++n) nxt[bj][n] = *(const f32x4*)(xin + offn + 128 * bj + 4 * n); }
            const size_t off = (size_t)(rl0 + ai * 128 + m * 16) * D + c0;
#pragma unroll
            for (int bj = 0; bj < 2; ++bj)
#pragma unroll
                for (int n = 0; n < 2; ++n) *(f32x4*)(xout + off + 128 * bj + 4 * n) = cur[bj][n] + gv[bj][n] * acc[ai][bj][m][n];
#pragma unroll
            for (int bj = 0; bj < 2; ++bj)
#pragma unroll
                for (int n = 0; n < 2; ++n) cur[bj][n] = nxt[bj][n];
            asm volatile("" ::: "memory"); }
    }
};
struct EpiFinal {
    static constexpr bool AFTER_DRAIN = true, TRANSFORM = false;
    unsigned char* arena; const float* gt; const float* fg; float* out; float* xch; unsigned* cnt;
    __device__ __forceinline__ void fused(f32x4 (&acc)[2][2][4][2], const pg8::Unit& u, int wr, int wc, int fr, int fq, LAS unsigned char* lds, int wid, int lane) const {
        EPI_ROWS; const int c0 = 256 * u.pn + wc * 32 + fq * 8, b = u.pm >> 3; f32x4 gv[2][2];
        const bf16_t* xin = (const bf16_t*)(ab + AO_X1);
#pragma unroll
        for (int bj = 0; bj < 2; ++bj)
#pragma unroll
            for (int n = 0; n < 2; ++n) gv[bj][n] = *(const f32x4*)(gt + (size_t)b * MSTR + c0 + 128 * bj + 4 * n);
        u32x4 cur[2], nxt[2];
        { const size_t off = (size_t)rl0 * D + c0;
#pragma unroll
          for (int bj = 0; bj < 2; ++bj) cur[bj] = *(const u32x4*)(xin + off + 128 * bj); }
        LAS float* P = (LAS float*)lds; LAS float* S = (LAS float*)(lds + 4096);
#pragma unroll
        for (int g = 0; g < 8; ++g) { const int ai = g >> 2, m = g & 3;
            if (g < 7) { const size_t offn = (size_t)(rl0 + ((g + 1) >> 2) * 128 + ((g + 1) & 3) * 16) * D + c0;
#pragma unroll
                for (int bj = 0; bj < 2; ++bj) nxt[bj] = *(const u32x4*)(xin + offn + 128 * bj); }
            float sq = 0.f;
#pragma unroll
            for (int bj = 0; bj < 2; ++bj) { f32x4 xc[2]; unpack8(cur[bj], xc[0], xc[1]);
#pragma unroll
                for (int n = 0; n < 2; ++n) { const f32x4 v = xc[n] + gv[bj][n] * acc[ai][bj][m][n]; acc[ai][bj][m][n] = v; sq += (v[0] * v[0] + v[1] * v[1]) + (v[2] * v[2] + v[3] * v[3]); } }
            sq += __shfl_xor(sq, 16); sq += __shfl_xor(sq, 32);
            if (fq == 0) P[(ai * 128 + wr * 64 + m * 16 + fr) * 4 + wc] = sq;
#pragma unroll
            for (int bj = 0; bj < 2; ++bj) cur[bj] = nxt[bj]; }
        asm volatile("s_waitcnt lgkmcnt(0)" ::: "memory"); __builtin_amdgcn_s_barrier(); asm volatile("" ::: "memory");
        const int tid = wid * 64 + lane;
        if (tid < 256) { const float bp = (P[tid * 4] + P[tid * 4 + 1]) + (P[tid * 4 + 2] + P[tid * 4 + 3]);
            __hip_atomic_store(xch + ((size_t)u.pm * 256 + tid) * 4 + u.pn, bp, __ATOMIC_RELAXED, __HIP_MEMORY_SCOPE_AGENT); }
        asm volatile("s_waitcnt vmcnt(0)" ::: "memory");
        if (tid < 256 && lane == 0) __hip_atomic_fetch_add(cnt + u.pm * 16, 1u, __ATOMIC_RELAXED, __HIP_MEMORY_SCOPE_AGENT);
        if (wid == 0) { unsigned spins = 0;
            while ((unsigned)__builtin_amdgcn_readfirstlane(__hip_atomic_load(cnt + u.pm * 16, __ATOMIC_RELAXED, __HIP_MEMORY_SCOPE_AGENT)) < 16u) { __builtin_amdgcn_s_sleep(2); if (++spins > (1u << 20)) break; }
            __builtin_amdgcn_fence(__ATOMIC_ACQUIRE, "agent"); asm volatile("s_waitcnt vmcnt(0)" ::: "memory"); }
        asm volatile("s_waitcnt vmcnt(0) lgkmcnt(0)" ::: "memory"); __builtin_amdgcn_s_barrier(); asm volatile("" ::: "memory");
        if (tid < 256) { const float* xr = xch + ((size_t)u.pm * 256 + tid) * 4;
            const float t = (__hip_atomic_load(xr, __ATOMIC_RELAXED, __HIP_MEMORY_SCOPE_AGENT) + __hip_atomic_load(xr + 1, __ATOMIC_RELAXED, __HIP_MEMORY_SCOPE_AGENT))
                          + (__hip_atomic_load(xr + 2, __ATOMIC_RELAXED, __HIP_MEMORY_SCOPE_AGENT) + __hip_atomic_load(xr + 3, __ATOMIC_RELAXED, __HIP_MEMORY_SCOPE_AGENT));
            S[tid] = rsqrtf(t * (1.f / D) + RMS_EPS); }
        asm volatile("s_waitcnt vmcnt(0) lgkmcnt(0)" ::: "memory"); __builtin_amdgcn_s_barrier(); asm volatile("" ::: "memory");
        f32x4 fgv[2][2];
#pragma unroll
        for (int bj = 0; bj < 2; ++bj)
#pragma unroll
            for (int n = 0; n < 2; ++n) fgv[bj][n] = *(const f32x4*)(fg + c0 + 128 * bj + 4 * n);
#pragma unroll
        for (int ai = 0; ai < 2; ++ai)
#pragma unroll
            for (int m = 0; m < 4; ++m) { const int lr = ai * 128 + wr * 64 + m * 16 + fr; const float r = S[lr]; float* orow = out + (size_t)(u.pm * 256 + lr) * D + c0;
#pragma unroll
                for (int bj = 0; bj < 2; ++bj)
#pragma unroll
                    for (int n = 0; n < 2; ++n) __builtin_nontemporal_store(acc[ai][bj][m][n] * r * fgv[bj][n], (f32x4*)(orow + 128 * bj + 4 * n)); }
    }
};
struct EpiResNorm {
    static constexpr bool AFTER_DRAIN = true, TRANSFORM = false;
    unsigned char* arena; const float* x; const float* mod; const float* g2; float* xch; unsigned* cnt;
    __device__ __forceinline__ void fused(f32x4 (&acc)[2][2][4][2], const pg8::Unit& u, int wr, int wc, int fr, int fq, LAS unsigned char* lds, int wid, int lane) const {
        EPI_ROWS; const int c0 = 256 * u.pn + wc * 32 + fq * 8, b = u.pm >> 3; const float* mb = mod + (size_t)b * MSTR;
        const float* xin = x + (size_t)b * SEQ * D; bf16_t* x1 = (bf16_t*)(ab + AO_X1); bf16_t* H2 = (bf16_t*)(ab + AO_A1);
        LAS float* P = (LAS float*)lds; LAS float* S = (LAS float*)(lds + 4096);
        { f32x4 gv[2][2], cur[2][2], nxt[2][2];
#pragma unroll
          for (int bj = 0; bj < 2; ++bj)
#pragma unroll
              for (int n = 0; n < 2; ++n) gv[bj][n] = *(const f32x4*)(mb + MO_GT1 + c0 + 128 * bj + 4 * n);
          { const size_t off = (size_t)rl0 * D + c0;
#pragma unroll
            for (int bj = 0; bj < 2; ++bj)
#pragma unroll
                for (int n = 0; n < 2; ++n) cur[bj][n] = *(const f32x4*)(xin + off + 128 * bj + 4 * n); }
#pragma unroll
          for (int g = 0; g < 8; ++g) { const int ai = g >> 2, m = g & 3;
              if (g < 7) { const size_t offn = (size_t)(rl0 + ((g + 1) >> 2) * 128 + ((g + 1) & 3) * 16) * D + c0;
#pragma unroll
                  for (int bj = 0; bj < 2; ++bj)
#pragma unroll
                      for (int n = 0; n < 2; ++n) nxt[bj][n] = *(const f32x4*)(xin + offn + 128 * bj + 4 * n); }
              float sq = 0.f;
#pragma unroll
              for (int bj = 0; bj < 2; ++bj)
#pragma unroll
                  for (int n = 0; n < 2; ++n) { const f32x4 v = cur[bj][n] + gv[bj][n] * acc[ai][bj][m][n]; acc[ai][bj][m][n] = v; sq += (v[0] * v[0] + v[1] * v[1]) + (v[2] * v[2] + v[3] * v[3]); }
              sq += __shfl_xor(sq, 16); sq += __shfl_xor(sq, 32);
              if (fq == 0) P[(ai * 128 + wr * 64 + m * 16 + fr) * 4 + wc] = sq;
#pragma unroll
              for (int bj = 0; bj < 2; ++bj)
#pragma unroll
                  for (int n = 0; n < 2; ++n) cur[bj][n] = nxt[bj][n]; } }
        asm volatile("s_waitcnt lgkmcnt(0)" ::: "memory"); __builtin_amdgcn_s_barrier(); asm volatile("" ::: "memory");
        const int tid = wid * 64 + lane;
        if (tid < 256) { const float bp = (P[tid * 4] + P[tid * 4 + 1]) + (P[tid * 4 + 2] + P[tid * 4 + 3]);
            __hip_atomic_store(xch + ((size_t)u.pm * 256 + tid) * 4 + u.pn, bp, __ATOMIC_RELAXED, __HIP_MEMORY_SCOPE_AGENT); }
        asm volatile("s_waitcnt vmcnt(0)" ::: "memory");
        if (tid < 256 && lane == 0) __hip_atomic_fetch_add(cnt + u.pm * 16, 1u, __ATOMIC_RELAXED, __HIP_MEMORY_SCOPE_AGENT);
        if (wid == 0) { unsigned spins = 0;
            while ((unsigned)__builtin_amdgcn_readfirstlane(__hip_atomic_load(cnt + u.pm * 16, __ATOMIC_RELAXED, __HIP_MEMORY_SCOPE_AGENT)) < 16u) { __builtin_amdgcn_s_sleep(2); if (++spins > (1u << 20)) break; }
            __builtin_amdgcn_fence(__ATOMIC_ACQUIRE, "agent"); asm volatile("s_waitcnt vmcnt(0)" ::: "memory"); }
        asm volatile("s_waitcnt vmcnt(0) lgkmcnt(0)" ::: "memory"); __builtin_amdgcn_s_barrier(); asm volatile("" ::: "memory");
        if (tid < 256) { const float* xr = xch + ((size_t)u.pm * 256 + tid) * 4;
            const float t = (__hip_atomic_load(xr, __ATOMIC_RELAXED, __HIP_MEMORY_SCOPE_AGENT) + __hip_atomic_load(xr + 1, __ATOMIC_RELAXED, __HIP_MEMORY_SCOPE_AGENT))
                          + (__hip_atomic_load(xr + 2, __ATOMIC_RELAXED, __HIP_MEMORY_SCOPE_AGENT) + __hip_atomic_load(xr + 3, __ATOMIC_RELAXED, __HIP_MEMORY_SCOPE_AGENT));
            S[tid] = rsqrtf(t * (1.f / D) + RMS_EPS); }
        asm volatile("s_waitcnt vmcnt(0) lgkmcnt(0)" ::: "memory"); __builtin_amdgcn_s_barrier(); asm volatile("" ::: "memory");
        f32x4 mul[2][2], sh[2][2];
#pragma unroll
        for (int bj = 0; bj < 2; ++bj)
#pragma unroll
            for (int n = 0; n < 2; ++n) { const int col = c0 + 128 * bj + 4 * n; const f32x4 gg = *(const f32x4*)(g2 + col), sc = *(const f32x4*)(mb + MO_SC2 + col);
                sh[bj][n] = *(const f32x4*)(mb + MO_SH2 + col); mul[bj][n] = gg * (sc + 1.0f); }
#pragma unroll
        for (int ai = 0; ai < 2; ++ai)
#pragma unroll
            for (int m = 0; m < 4; ++m) { const int lr = ai * 128 + wr * 64 + m * 16 + fr; const float r = S[lr]; const size_t off = (size_t)(rl0 + ai * 128 + m * 16) * D + c0;
#pragma unroll
                for (int bj = 0; bj < 2; ++bj) {
                    *(u32x4*)(x1 + off + 128 * bj) = pack8(acc[ai][bj][m][0], acc[ai][bj][m][1]);
                    *(u32x4*)(H2 + off + 128 * bj) = pack8(acc[ai][bj][m][0] * r * mul[bj][0] + sh[bj][0], acc[ai][bj][m][1] * r * mul[bj][1] + sh[bj][1]); } }
    }
};
struct EpiGU {
    static constexpr bool AFTER_DRAIN = false, TRANSFORM = false;
    unsigned char* arena;
    __device__ __forceinline__ void operator()(AccRef acc, const pg8::Unit& u, int wr, int wc, int fr, int fq) const {
        EPI_ROWS; const int cA = 128 * u.pn + wc * 32 + fq * 8; bf16_t* ACT = (bf16_t*)(ab + AO_ACT);
#pragma unroll
        for (int ai = 0; ai < 2; ++ai)
#pragma unroll
            for (int m = 0; m < 4; ++m) { f32x4 r[2];
#pragma unroll
                for (int n = 0; n < 2; ++n) { const f32x4 a = acc[ai][0][m][n], b = acc[ai][1][m][n];
#pragma unroll
                    for (int j = 0; j < 4; ++j) r[n][j] = a[j] * sigm(a[j]) * b[j]; }
                *(u32x4*)(ACT + (size_t)(rl0 + ai * 128 + m * 16) * DFF + cA) = pack8(r[0], r[1]); }
    }
};

__device__ __forceinline__ void p0_mod(const Args& a, float* mod, LAS unsigned char* lds, int item, int tid, int lane, int wave) {
    LAS float* cs = (LAS float*)lds; LAS float* red = (LAS float*)(lds + 32768);
    for (int i = tid; i < NB * D; i += 512) { const int b = i >> 10, k = i & 1023; const float v = a.c[i]; cs[k * 8 + b] = v * sigm(v); }
    __syncthreads();
    const int jl = lane & 31, j = item * 32 + jl, kg = wave * 2 + (lane >> 5);
    float s0 = 0.f, s1 = 0.f, s2 = 0.f, s3 = 0.f, s4 = 0.f, s5 = 0.f, s6 = 0.f, s7 = 0.f;
#pragma unroll 16
    for (int kk = 0; kk < 64; ++kk) { const int k = kg * 64 + kk; const float w = a.w_ada[(size_t)k * NMOD + j];
        const f32x4 c0 = *(const LAS f32x4*)(cs + k * 8), c1 = *(const LAS f32x4*)(cs + k * 8 + 4);
        s0 += w * c0[0]; s1 += w * c0[1]; s2 += w * c0[2]; s3 += w * c0[3]; s4 += w * c1[0]; s5 += w * c1[1]; s6 += w * c1[2]; s7 += w * c1[3]; }
    red[(kg * 8 + 0) * 32 + jl] = s0; red[(kg * 8 + 1) * 32 + jl] = s1; red[(kg * 8 + 2) * 32 + jl] = s2; red[(kg * 8 + 3) * 32 + jl] = s3;
    red[(kg * 8 + 4) * 32 + jl] = s4; red[(kg * 8 + 5) * 32 + jl] = s5; red[(kg * 8 + 6) * 32 + jl] = s6; red[(kg * 8 + 7) * 32 + jl] = s7;
    __syncthreads();
    if (tid < 256) { const int b = tid >> 5, jj = tid & 31; float s = 0.f;
#pragma unroll
        for (int g = 0; g < 16; ++g) s += red[(g * 8 + b) * 32 + jj];
        mod[(size_t)b * MSTR + item * 32 + jj] = s + a.b_ada[item * 32 + jj]; }
    __syncthreads();
}
__device__ __forceinline__ void p0_mod_ksplit(const Args& a, float* part, LAS unsigned char* lds, int item, int tid, int lane, int wave) {
    LAS float* cs = (LAS float*)lds; LAS float* red = (LAS float*)(lds + 4096);
    const int g = item >> 3, kc = item & 7;
    for (int i = tid; i < 128 * NB; i += 512) { const int b = i >> 7, k = i & 127; const float v = a.c[b * D + kc * 128 + k]; cs[k * 8 + b] = v * sigm(v); }
    f32x4 wv[16];
#pragma unroll
    for (int i = 0; i < 16; ++i) wv[i] = *(const f32x4*)(a.w_ada + (size_t)(kc * 128 + wave * 16 + i) * NMOD + g * 256 + 4 * lane);
    __syncthreads();
    f32x4 acc[8];
#pragma unroll
    for (int b = 0; b < 8; ++b) acc[b] = (f32x4){0.f, 0.f, 0.f, 0.f};
#pragma unroll
    for (int i = 0; i < 16; ++i) { const int k = wave * 16 + i; const f32x4 c0 = *(const LAS f32x4*)(cs + k * 8), c1 = *(const LAS f32x4*)(cs + k * 8 + 4);
        acc[0] += wv[i] * c0[0]; acc[1] += wv[i] * c0[1]; acc[2] += wv[i] * c0[2]; acc[3] += wv[i] * c0[3];
        acc[4] += wv[i] * c1[0]; acc[5] += wv[i] * c1[1]; acc[6] += wv[i] * c1[2]; acc[7] += wv[i] * c1[3]; }
#pragma unroll
    for (int b = 0; b < 8; ++b) *(LAS f32x4*)(red + (wave * 8 + b) * 256 + 4 * lane) = acc[b];
    __syncthreads();
    { const int b = tid >> 6, c4 = tid & 63; f32x4 sacc = (f32x4){0.f, 0.f, 0.f, 0.f};
#pragma unroll
      for (int w = 0; w < 8; ++w) sacc += *(const LAS f32x4*)(red + (w * 8 + b) * 256 + 4 * c4);
      *(f32x4*)(part + ((size_t)kc * NB + b) * NMOD + g * 256 + 4 * c4) = sacc; }
    __syncthreads();
}
__device__ __forceinline__ void transpose_item(const float* W, int K, int N, bf16_t* WT, int k0, int nsrc0, int rdst0, LAS float* scr, int lane) {
    { float tv[32];
#pragma unroll
      for (int i = 0; i < 32; ++i) { const int kk = 2 * i + (lane >> 5); tv[i] = W[(size_t)(k0 + kk) * N + nsrc0 + (lane & 31)]; }
#pragma unroll
      for (int i = 0; i < 32; ++i) { const int kk = 2 * i + (lane >> 5); scr[kk * 33 + (lane & 31)] = tv[i]; } }
    asm volatile("s_waitcnt lgkmcnt(0)" ::: "memory");
    const int c = lane & 7;
#pragma unroll
    for (int j = 0; j < 4; ++j) { const int n = (lane >> 3) + 8 * j; const LAS float* s = scr + (8 * c) * 33 + n;
        u32x4 o; o.x = cvt_pk_bf16(s[0 * 33], s[1 * 33]); o.y = cvt_pk_bf16(s[2 * 33], s[3 * 33]); o.z = cvt_pk_bf16(s[4 * 33], s[5 * 33]); o.w = cvt_pk_bf16(s[6 * 33], s[7 * 33]);
        *(u32x4*)(WT + (size_t)(rdst0 + n) * K + k0 + 8 * c) = o; }
    asm volatile("s_waitcnt lgkmcnt(0)" ::: "memory");
}
__device__ __forceinline__ void p0_convert_win_block(const Args& a, unsigned char* ws, LAS unsigned char* lds, int bitem, int lane, int wave) {
    LAS float* tile = (LAS float*)lds; bf16_t* WT = (bf16_t*)(ws + WS_WIN);
    const int kb = bitem / (DIN / 256), nbt = bitem % (DIN / 256), k0 = 64 * kb, h = lane >> 5, c4 = lane & 31;
    const int src0 = map_in(256 * nbt + 128 * h) + 4 * c4;
    f32x4 v[8];
#pragma unroll
    for (int i = 0; i < 8; ++i) v[i] = *(const f32x4*)(a.w_in + (size_t)(k0 + wave * 8 + i) * DIN + src0);
#pragma unroll
    for (int i = 0; i < 8; ++i) *(LAS f32x4*)(tile + (wave * 8 + i) * 260 + 128 * h + 4 * c4) = v[i];
    __syncthreads();
    const int c = lane & 7;
#pragma unroll
    for (int j = 0; j < 4; ++j) { const int n = wave * 32 + (lane >> 3) + 8 * j; const LAS float* sp = tile + (8 * c) * 260 + n;
        u32x4 o; o.x = cvt_pk_bf16(sp[0 * 260], sp[1 * 260]); o.y = cvt_pk_bf16(sp[2 * 260], sp[3 * 260]); o.z = cvt_pk_bf16(sp[4 * 260], sp[5 * 260]); o.w = cvt_pk_bf16(sp[6 * 260], sp[7 * 260]);
        *(u32x4*)(WT + (size_t)(256 * nbt + n) * D + k0 + 8 * c) = o; }
    __syncthreads();
}
constexpr int I_IN = (D / 64) * (DIN / 32), I_A = (DC / 64) * (D / 32), I_B = I_A, I_O = (D / 64) * (D / 32), I_GU = (D / 64) * (NGU / 32), I_DN = (DFF / 64) * (D / 32);
constexpr int NITEMS = I_IN + I_A + I_B + I_O + I_GU + I_DN;
__device__ __forceinline__ void p0_convert(const Args& a, unsigned char* ws, LAS unsigned char* lds, int gw, int NGW, int wave, int lane, int first, int last) {
    LAS float* scr = (LAS float*)(lds + 49152 + wave * 8448);
    for (int it = first + gw; it < last; it += NGW) {
        int r = it;
        if (r < I_IN) { const int nblk = DIN / 32, kb = r / nblk, nb = r % nblk; transpose_item(a.w_in, D, DIN, (bf16_t*)(ws + WS_WIN), 64 * kb, map_in(32 * nb), 32 * nb, scr, lane); continue; } r -= I_IN;
        if (r < I_A) { const int nblk = D / 32, kb = r / nblk, nb = r % nblk; transpose_item(a.conf_w_out, DC, D, (bf16_t*)(ws + WS_WA), 64 * kb, 32 * nb, 32 * nb, scr, lane); continue; } r -= I_A;
        if (r < I_B) { const int nblk = D / 32, kb = r / nblk, nb = r % nblk; transpose_item(a.sc_w_out, DC, D, (bf16_t*)(ws + WS_WB), 64 * kb, 32 * nb, 32 * nb, scr, lane); continue; } r -= I_B;
        if (r < I_O) { const int nblk = D / 32, kb = r / nblk, nb = r % nblk; transpose_item(a.w_o, D, D, (bf16_t*)(ws + WS_WO), 64 * kb, 32 * nb, 32 * nb, scr, lane); continue; } r -= I_O;
        if (r < I_GU) { const int nblk = NGU / 32, kb = r / nblk, nb = r % nblk; transpose_item(a.w_gu, D, NGU, (bf16_t*)(ws + WS_WGU), 64 * kb, map_gu(32 * nb), 32 * nb, scr, lane); continue; } r -= I_GU;
        { const int nblk = D / 32, kb = r / nblk, nb = r % nblk; transpose_item(a.w_down, DFF, D, (bf16_t*)(ws + WS_WDN), 64 * kb, 32 * nb, 32 * nb, scr, lane); }
    }
}
__device__ __forceinline__ float sumsq4(const f32x4 (&v)[4]) { float ss = 0.f;
#pragma unroll
    for (int j = 0; j < 4; ++j) ss += (v[j][0] * v[j][0] + v[j][1] * v[j][1]) + (v[j][2] * v[j][2] + v[j][3] * v[j][3]);
    return ss; }
__device__ __forceinline__ int own_row(int i, int wave, int G, int c) { return (G == 256) ? (c & 7) * SEQ + (c >> 3) * 64 + wave * 8 + i : (c * 8 + wave) + i * (G * 8); }
__device__ __forceinline__ int own_cnt(int G) { return (G == 256) ? 8 : (M + G * 8 - 1) / (G * 8); }
__device__ __forceinline__ const float* x1_row(unsigned char* arena, int m) { return (const float*)(arena + (size_t)(m >> 11) * ARENA + AO_X1) + (size_t)(m & (SEQ - 1)) * D; }
__device__ __forceinline__ void rownorm_mod(const float* xg, unsigned char* arena, const float* g, const float* mod, int sh_off, int sc_off, int wave, int G, int lane, int vid, const float* part = nullptr, const float* bias = nullptr) {
    const int cnt = own_cnt(G); int m = own_row(0, wave, G, vid); if (m >= M) return;
    f32x4 cur[4], nxt[4], mul[4], sh[4]; int bcur = -1;
    { const f32x4* xr = (const f32x4*)(xg ? xg + (size_t)m * D : x1_row(arena, m)) + lane;
#pragma unroll
      for (int j = 0; j < 4; ++j) cur[j] = xr[64 * j]; }
    for (int it = 0; it < cnt && m < M; ++it) { const int mn = (it + 1 < cnt) ? own_row(it + 1, wave, G, vid) : M;
        if (mn < M) { const f32x4* xr = (const f32x4*)(xg ? xg + (size_t)mn * D : x1_row(arena, mn)) + lane;
#pragma unroll
            for (int j = 0; j < 4; ++j) nxt[j] = xr[64 * j]; }
        const int b = m >> 11;
        if (b != bcur) { bcur = b;
#pragma unroll
            for (int j = 0; j < 4; ++j) { const int col = 4 * lane + 256 * j; const f32x4 gv = *(const f32x4*)(g + col); f32x4 sc;
                if (part) {
                    sc = *(const f32x4*)(bias + sc_off + col); sh[j] = *(const f32x4*)(bias + sh_off + col);
#pragma unroll
                    for (int kc = 0; kc < 8; ++kc) { const float* pp = part + ((size_t)kc * NB + b) * NMOD; sc += *(const f32x4*)(pp + sc_off + col); sh[j] += *(const f32x4*)(pp + sh_off + col); }
                } else { sc = *(const f32x4*)(mod + (size_t)b * MSTR + sc_off + col); sh[j] = *(const f32x4*)(mod + (size_t)b * MSTR + sh_off + col); }
                mul[j] = gv * (sc + 1.0f); } }
        const float rstd = rsqrtf(wave_sum(sumsq4(cur)) * (1.f / D) + RMS_EPS);
        u32x2* o8 = (u32x2*)((bf16_t*)(arena + (size_t)b * ARENA + AO_A1) + (size_t)(m & (SEQ - 1)) * D) + lane;
#pragma unroll
        for (int j = 0; j < 4; ++j) { const f32x4 o = cur[j] * rstd * mul[j] + sh[j]; u32x2 w; w.x = cvt_pk_bf16(o[0], o[1]); w.y = cvt_pk_bf16(o[2], o[3]); o8[64 * j] = w; }
#pragma unroll
        for (int j = 0; j < 4; ++j) cur[j] = nxt[j];
        m = mn; }
}
__device__ __forceinline__ void final_norm(unsigned char* arena, float* O, const float* g, int wave, int G, int lane, int vid) {
    f32x4 gv[4];
#pragma unroll
    for (int j = 0; j < 4; ++j) gv[j] = *(const f32x4*)(g + 4 * lane + 256 * j);
    const int cnt = own_cnt(G); f32x4 cur[4], nxt[4]; int m = own_row(0, wave, G, vid);
    if (m < M) { const f32x4* xr = (const f32x4*)x1_row(arena, m) + lane;
#pragma unroll
        for (int j = 0; j < 4; ++j) cur[j] = xr[64 * j]; }
    for (int it = 0; it < cnt && m < M; ++it) { const int mn = (it + 1 < cnt) ? own_row(it + 1, wave, G, vid) : M;
        if (mn < M) { const f32x4* xr = (const f32x4*)x1_row(arena, mn) + lane;
#pragma unroll
            for (int j = 0; j < 4; ++j) nxt[j] = xr[64 * j]; }
        const float rstd = rsqrtf(wave_sum(sumsq4(cur)) * (1.f / D) + RMS_EPS);
        f32x4* orow = (f32x4*)(O + (size_t)m * D) + lane;
#pragma unroll
        for (int j = 0; j < 4; ++j) orow[64 * j] = cur[j] * rstd * gv[j];
#pragma unroll
        for (int j = 0; j < 4; ++j) cur[j] = nxt[j];
        m = mn; }
}
__device__ __forceinline__ void p3_conv(const Args& a, unsigned char* arena, LAS unsigned char* lds, int tid, int lane, int wave, int vid) {
    LAS unsigned* buf = (LAS unsigned*)lds; LAS float* red = (LAS float*)(lds + 94 * 1024);
    const int cp = tid & 255, th = tid >> 8, w4 = wave & 3;
    f32x2 w[CONF_K];
#pragma unroll
    for (int k = 0; k < CONF_K; ++k) w[k] = *(const f32x2*)(a.conf_dw_w + k * DC + 2 * cp);
    const f32x2 cb = *(const f32x2*)(a.conf_dw_b + 2 * cp), lg = *(const f32x2*)(a.conf_ln_g + 2 * cp), lb = *(const f32x2*)(a.conf_ln_b + 2 * cp);
    const f32x2 w30 = *(const f32x2*)(a.sc_dw_w + 2 * cp), w31 = *(const f32x2*)(a.sc_dw_w + DC + 2 * cp), w32 = *(const f32x2*)(a.sc_dw_w + 2 * DC + 2 * cp);
    for (int tl = vid; tl < M / 64; tl += gridDim.x) {
        const int tile = (gridDim.x == 256) ? (tl & 7) * 32 + (tl >> 3) : tl;
        const int b = tile >> 5, t0 = (tile & 31) * 64;
        unsigned char* ab = arena + (size_t)b * ARENA;
        const bf16_t* U = (const bf16_t*)(ab + AO_U); const unsigned* GCV = (const unsigned*)(ab + AO_GCV); const unsigned* GBp = (const unsigned*)(ab + AO_GB);
        unsigned* UA = (unsigned*)(ab + AO_UA); unsigned* VB = (unsigned*)(ab + AO_VB);
        __syncthreads();
        { u32x4 sv[12];
#pragma unroll
          for (int i = 0; i < 12; ++i) { const int ch = tid + 512 * i, row = ch >> 6, c16 = ch & 63; sv[i] = (u32x4){0u, 0u, 0u, 0u};
              if (ch < 94 * 64 && (t0 != 0 || row >= 30)) sv[i] = *(const u32x4*)(U + (size_t)(t0 - 30 + row) * DC + c16 * 8); }
#pragma unroll
          for (int i = 0; i < 12; ++i) { const int ch = tid + 512 * i, row = ch >> 6, c16 = ch & 63; if (ch < 94 * 64) *(LAS u32x4*)(lds + row * 1024 + c16 * 16) = sv[i]; } }
        __syncthreads();
#pragma unroll 1
        for (int chunk = 0; chunk < 4; ++chunk) {
            const int tb = t0 + th * 32 + chunk * 8; unsigned gc[10], gbv[8];
            { const bool head = (tb == 0);
              gc[0] = head ? 0u : GCV[(size_t)(tb - 2) * (DC / 2) + cp]; gc[1] = head ? 0u : GCV[(size_t)(tb - 1) * (DC / 2) + cp];
#pragma unroll
              for (int tt = 0; tt < 8; ++tt) { gc[2 + tt] = GCV[(size_t)(tb + tt) * (DC / 2) + cp]; gbv[tt] = GBp[(size_t)(tb + tt) * (DC / 2) + cp]; } }
            float y0[8], y1[8];
#pragma unroll
            for (int tt = 0; tt < 8; ++tt) { const int lt = th * 32 + chunk * 8 + tt; float a0 = cb[0], a1 = cb[1];
#pragma unroll
                for (int k = 0; k < CONF_K; ++k) { const unsigned v = buf[(lt + k) * 256 + cp]; a0 += w[k][0] * bf_lo(v); a1 += w[k][1] * bf_hi(v); }
                y0[tt] = a0; y1[tt] = a1; }
#pragma unroll
            for (int tt = 0; tt < 8; ++tt) { const float sq = wave_sum(y0[tt] + y1[tt]), q = wave_sum(y0[tt] * y0[tt] + y1[tt] * y1[tt]);
                if (lane == 0) { red[((tt * 2 + th) * 4 + w4) * 2 + 0] = sq; red[((tt * 2 + th) * 4 + w4) * 2 + 1] = q; } }
            __syncthreads();
#pragma unroll
            for (int tt = 0; tt < 8; ++tt) { const int lt = th * 32 + chunk * 8 + tt; const LAS float* r = red + (tt * 2 + th) * 8;
                const float S = (r[0] + r[2]) + (r[4] + r[6]), Q = (r[1] + r[3]) + (r[5] + r[7]);
                const float mean = S * (1.f / DC), var = fmaxf(Q * (1.f / DC) - mean * mean, 0.f), rstd = rsqrtf(var + LN_EPS);
                const float z0 = (y0[tt] - mean) * rstd * lg[0] + lb[0], z1 = (y1[tt] - mean) * rstd * lg[1] + lb[1];
                UA[(size_t)(t0 + lt) * (DC / 2) + cp] = cvt_pk_bf16(z0 * sigm(z0), z1 * sigm(z1)); }
#pragma unroll
            for (int tt = 0; tt < 8; ++tt) { const unsigned p2 = gc[tt], p1 = gc[tt + 1], cur = gc[tt + 2], gb = gbv[tt];
                const float r0 = w30[0] * bf_lo(p2) + w31[0] * bf_lo(p1) + w32[0] * bf_lo(cur), r1 = w30[1] * bf_hi(p2) + w31[1] * bf_hi(p1) + w32[1] * bf_hi(cur);
                VB[(size_t)(tb + tt) * (DC / 2) + cp] = cvt_pk_bf16(bf_lo(gb) * r0, bf_hi(gb) * r1); }
            __syncthreads();
        }
    }
}

__global__ void __launch_bounds__(512, 2) mega(Args a) {
    extern __shared__ __attribute__((aligned(16))) unsigned char lds_raw[];
    LAS unsigned char* lds = (LAS unsigned char*)lds_raw;
    const int G = gridDim.x;
#define PHASE_IDS const int tid = opaque_tid(), lane = tid & 63, wave = __builtin_amdgcn_readfirstlane(tid >> 6); (void)tid; (void)lane; (void)wave
    unsigned char* ws = a.ws; unsigned char* arena = ws + WS_ARENA; float* mod = (float*)(arena + AO_MODX); float* modp = (float*)(ws + WS_MODP);
    volatile LAS unsigned* misc = (volatile LAS unsigned*)(lds + 131072);
    unsigned* ctl = (unsigned*)ws;
#define VID ((int)misc[2])
#define GRID_BARRIER(idx) do { asm volatile("s_waitcnt vmcnt(0) lgkmcnt(0)" ::: "memory"); __syncthreads(); \
        if (threadIdx.x == 0) { unsigned* bw = ctl + 1024 + 64 * (idx); __builtin_amdgcn_fence(__ATOMIC_RELEASE, "agent"); asm volatile("s_waitcnt vmcnt(0)" ::: "memory"); \
            __hip_atomic_fetch_add(bw, 1u, __ATOMIC_RELAXED, __HIP_MEMORY_SCOPE_AGENT); \
            while (__hip_atomic_load(bw, __ATOMIC_RELAXED, __HIP_MEMORY_SCOPE_AGENT) < gridDim.x) __builtin_amdgcn_s_sleep(1); \
            __builtin_amdgcn_fence(__ATOMIC_ACQUIRE, "agent"); asm volatile("s_waitcnt vmcnt(0)" ::: "memory"); } \
        __syncthreads(); asm volatile("" ::: "memory"); } while (0)
#define SEAM(k) do { if (misc[3] != 0u) { asm volatile("s_waitcnt vmcnt(0) lgkmcnt(0)" ::: "memory"); __syncthreads(); \
            if (threadIdx.x == 0) { unsigned* bw = ctl + 2048 + 64 * misc[0] + (k); __hip_atomic_fetch_add(bw, 1u, __ATOMIC_RELAXED, __HIP_MEMORY_SCOPE_AGENT); \
                while (__hip_atomic_load(bw, __ATOMIC_RELAXED, __HIP_MEMORY_SCOPE_AGENT) < 32u) __builtin_amdgcn_s_sleep(1); \
                __builtin_amdgcn_fence(__ATOMIC_ACQUIRE, "agent"); asm volatile("s_waitcnt vmcnt(0)" ::: "memory"); } \
            __syncthreads(); asm volatile("" ::: "memory"); } else GRID_BARRIER(k); } while (0)

    if (threadIdx.x == 0) { const unsigned xcc = (unsigned)__builtin_amdgcn_s_getreg((3 << 11) | 20) & 0xFu;
        misc[0] = xcc; misc[1] = __hip_atomic_fetch_add(ctl + 64 * xcc, 1u, __ATOMIC_RELAXED, __HIP_MEMORY_SCOPE_AGENT); misc[2] = blockIdx.x; misc[3] = 0u; }

    { PHASE_IDS; const int gw = ((G == 256) ? (int)((blockIdx.x + 64u) & 255u) : (int)blockIdx.x) * 8 + wave, NGW = G * 8;
        if (G == 256) { if (blockIdx.x < 192) p0_mod_ksplit(a, modp, lds, blockIdx.x, tid, lane, wave); }
        else if (G > 256) { if (blockIdx.x < 192) p0_mod(a, mod, lds, blockIdx.x, tid, lane, wave); }
        else { for (int it = blockIdx.x; it < 192; it += G) p0_mod(a, mod, lds, it, tid, lane, wave); }
        if (G == 256) {
            p0_convert_win_block(a, ws, lds, (int)blockIdx.x, lane, wave);
            if (blockIdx.x >= 224) p0_convert_win_block(a, ws, lds, 256 + (int)blockIdx.x - 224, lane, wave);
        } else p0_convert(a, ws, lds, gw, NGW, wave, lane, 0, NITEMS);
    }
    if (gridDim.x == 0xFFFFFFFFu) cg::this_grid().sync();
    GRID_BARRIER(0);
    if (threadIdx.x == 0) {
        bool even = (G == 256);
        for (int j = 0; j < 16; ++j) { const unsigned cnt = __hip_atomic_load(ctl + 64 * j, __ATOMIC_RELAXED, __HIP_MEMORY_SCOPE_AGENT); if (cnt != (j < 8 ? 32u : 0u)) even = false; }
        if (even) { misc[2] = misc[1] * 8u + misc[0]; misc[3] = 1u; } }
    __syncthreads();

    if (G == 256) { PHASE_IDS; const int vid = VID, b = vid & 7, col = (vid >> 3) * 192 + tid;
        if (tid < 192) { float sv = a.b_ada[col];
#pragma unroll
            for (int kc = 0; kc < 8; ++kc) sv += modp[((size_t)kc * NB + b) * NMOD + col];
            mod[(size_t)b * MSTR + col] = sv; }
        rownorm_mod(a.x, arena, a.norm1_g, mod, MO_SH1, MO_SC1, wave, G, lane, vid, modp, a.b_ada);
    } else { PHASE_IDS; rownorm_mod(a.x, arena, a.norm1_g, mod, MO_SH1, MO_SC1, wave, G, lane, VID); }
    SEAM(1);
    { pg8::Gemm g{arena, (unsigned)AO_A1, 0u, (const bf16_t*)(ws + WS_WIN), nullptr, D}; pg8::Order S; S.init(M, DIN, G, VID, 0);
      EpiIn E{arena, a.b_glu, a.b_gate}; pg8::gemm_phase(lds, g, S, E); }
    if (G == 256 && VID >= 128) { PHASE_IDS;
        p0_convert(a, ws, lds, (VID - 128) * 8 + wave, 1024, wave, lane, I_IN, NITEMS);
        asm volatile("s_waitcnt vmcnt(0) lgkmcnt(0)" ::: "memory"); __syncthreads();
        if (threadIdx.x == 0) { __builtin_amdgcn_fence(__ATOMIC_RELEASE, "agent"); asm volatile("s_waitcnt vmcnt(0)" ::: "memory");
            __hip_atomic_fetch_add(ctl + 1792, 1u, __ATOMIC_RELAXED, __HIP_MEMORY_SCOPE_AGENT); } }
    SEAM(2);
    { PHASE_IDS; p3_conv(a, arena, lds, tid, lane, wave, VID); }
    if (G == 256 && threadIdx.x == 0) { unsigned spins = 0;
        while (__hip_atomic_load(ctl + 1792, __ATOMIC_RELAXED, __HIP_MEMORY_SCOPE_AGENT) < 128u) { __builtin_amdgcn_s_sleep(2); if (++spins > (1u << 20)) break; } }
    SEAM(3);
    { pg8::Gemm g{arena, (unsigned)AO_UA, (unsigned)AO_VB, (const bf16_t*)(ws + WS_WA), (const bf16_t*)(ws + WS_WB), DC}; pg8::Order S; S.init(M, D, G, VID, 1);
      EpiDual E{arena, a.conf_b_out}; pg8::gemm_phase(lds, g, S, E); }
    SEAM(4);
    if (G == 256) {
        pg8::Gemm g{arena, (unsigned)AO_MIX, 0u, (const bf16_t*)(ws + WS_WO), nullptr, D}; pg8::Order S; S.init(M, D, G, VID, 0);
        EpiResNorm E{arena, a.x, mod, a.norm2_g, (float*)(ws + WS_XCH + 512 * 1024), ctl + 6144}; pg8::gemm_phase(lds, g, S, E);
        SEAM(5);
    } else {
        { pg8::Gemm g{arena, (unsigned)AO_MIX, 0u, (const bf16_t*)(ws + WS_WO), nullptr, D}; pg8::Order S; S.init(M, D, G, VID, 0);
          EpiRes<true> E{arena, a.x, mod + MO_GT1}; pg8::gemm_phase(lds, g, S, E); }
        SEAM(5);
        { PHASE_IDS; rownorm_mod(nullptr, arena, a.norm2_g, mod, MO_SH2, MO_SC2, wave, G, lane, VID); }
        SEAM(6);
    }
    { pg8::Gemm g{arena, (unsigned)AO_A1, 0u, (const bf16_t*)(ws + WS_WGU), nullptr, D}; pg8::Order S; S.init(M, NGU, G, VID, 0);
      EpiGU E{arena}; pg8::gemm_phase(lds, g, S, E); }
    SEAM(7);
    if (G == 256) {
        pg8::Gemm g{arena, (unsigned)AO_ACT, 0u, (const bf16_t*)(ws + WS_WDN), nullptr, DFF}; pg8::Order S; S.init(M, D, G, VID, 0);
        EpiFinal E{arena, mod + MO_GT2, a.final_g, a.out, (float*)(ws + WS_XCH), ctl + 4096}; pg8::gemm_phase(lds, g, S, E);
    } else {
        { pg8::Gemm g{arena, (unsigned)AO_ACT, 0u, (const bf16_t*)(ws + WS_WDN), nullptr, DFF}; pg8::Order S; S.init(M, D, G, VID, 0);
          EpiRes<false> E{arena, nullptr, mod + MO_GT2}; pg8::gemm_phase(lds, g, S, E); }
        SEAM(8);
        { PHASE_IDS; final_norm(arena, a.out, a.final_g, wave, G, lane, VID); }
    }
#undef SEAM
#undef GRID_BARRIER
#undef VID
#undef PHASE_IDS
}

extern "C" void kernel_launch(void* const* d_in, const int* in_sizes, int n_in, void* d_out, int out_size, void* d_ws, size_t ws_size, hipStream_t stream) {
    static int grid = 0;
    if (grid == 0) {
        if (n_in != 21 || out_size != M * D || ws_size < WS_END) { fprintf(stderr, "kernel_launch: unexpected shapes (n_in %d out %d ws %zu)\n", n_in, out_size, ws_size); grid = -1; return; }
        int dev = 0, cus = 0, per_cu = 0;
        (void)hipGetDevice(&dev); (void)hipDeviceGetAttribute(&cus, hipDeviceAttributeMultiprocessorCount, dev);
        if (hipFuncSetAttribute((const void*)mega, hipFuncAttributeMaxDynamicSharedMemorySize, LDS_BYTES) != hipSuccess) { fprintf(stderr, "kernel_launch: hipFuncSetAttribute failed\n"); grid = -1; return; }
        if (hipOccupancyMaxActiveBlocksPerMultiprocessor(&per_cu, (const void*)mega, 512, LDS_BYTES) != hipSuccess || per_cu < 1) { fprintf(stderr, "kernel_launch: occupancy query gave %d\n", per_cu); per_cu = 1; }
        (void)hipGetLastError();
        grid = cus * per_cu;
    }
    if (grid < 0) return;
    Args a{};
    const float** ap = (const float**)&a;
    for (int i = 0; i < 21; ++i) ap[i] = (const float*)d_in[i];
    a.out = (float*)d_out; a.ws = (unsigned char*)d_ws; a.ph_lo = 0; a.ph_hi = 10;
    (void)hipMemsetAsync(d_ws, 0, 32768, stream);
    void* args[] = {&a};
    hipError_t e = hipLaunchCooperativeKernel((const void*)mega, dim3(grid), dim3(512), args, LDS_BYTES, stream);
    if (e != hipSuccess) fprintf(stderr, "cooperative launch failed: %s (grid %d)\n", hipGetErrorString(e), grid);
}
```

```cpp
#include <hip/hip_runtime.h>
#include <hip/hip_cooperative_groups.h>
#include <cstdio>
#include <cstdint>
namespace cg = cooperative_groups;


#define LAS __attribute__((address_space(3)))
typedef unsigned short bf16_t;
typedef short bf16x8 __attribute__((ext_vector_type(8)));
typedef float f32x4 __attribute__((ext_vector_type(4)));
typedef float f32x2 __attribute__((ext_vector_type(2)));
typedef unsigned u32x4 __attribute__((ext_vector_type(4)));
typedef unsigned u32x2 __attribute__((ext_vector_type(2)));

constexpr int NB = 8, SEQ = 2048, D = 1024, M = NB * SEQ, DC = 512, DIN = 4608, DFF = 2816, NGU = 2 * DFF, NMOD = 6 * D;
constexpr int CONF_K = 31;
constexpr float RMS_EPS = 1e-6f, LN_EPS = 1e-5f;
constexpr int MO_SH1 = 0, MO_SC1 = D, MO_GT1 = 2 * D, MO_SH2 = 3 * D, MO_SC2 = 4 * D, MO_GT2 = 5 * D;

constexpr size_t MiB = 1u << 20;
constexpr size_t WS_MOD = 1 * MiB;
constexpr size_t WS_XCH = 2 * MiB;
constexpr size_t WS_WIN = 8 * MiB;
constexpr size_t WS_WA = 17 * MiB;
constexpr size_t WS_WB = 18 * MiB;
constexpr size_t WS_WO = 19 * MiB;
constexpr size_t WS_WGU = 21 * MiB;
constexpr size_t WS_WDN = 32 * MiB;
constexpr size_t WS_ARENA = 40 * MiB, ARENA = 24 * MiB;
constexpr size_t AO_A1 = 0;
constexpr size_t AO_UA = 0, AO_VB = 2 * MiB;
constexpr size_t AO_U = 4 * MiB, AO_GCV = 6 * MiB, AO_GB = 8 * MiB;
constexpr size_t AO_T = 4 * MiB;
constexpr size_t AO_MIX = 10 * MiB;
constexpr size_t AO_ACT = 4 * MiB;
constexpr size_t AO_GATES = 15 * MiB;
constexpr size_t AO_X1 = 15 * MiB;
constexpr size_t AO_MODX = 23 * MiB;
constexpr size_t WS_MODP = 3 * MiB;
constexpr int MSTR = (int)(ARENA / 4);
constexpr size_t WS_END = WS_ARENA + 8 * ARENA;
constexpr int LDS_BYTES = 131072 + 2048;

struct Args {
    const float *x, *c, *w_ada, *b_ada, *norm1_g, *w_in, *b_glu, *conf_dw_w, *conf_dw_b, *conf_ln_g, *conf_ln_b, *conf_w_out, *conf_b_out,
        *sc_dw_w, *sc_w_out, *b_gate, *w_o, *norm2_g, *w_gu, *w_down, *final_g;
    float* out; unsigned char* ws; int ph_lo, ph_hi;
};

__device__ __forceinline__ float bf_lo(unsigned v) { return __uint_as_float(v << 16); }
__device__ __forceinline__ float bf_hi(unsigned v) { return __uint_as_float(v & 0xffff0000u); }
__device__ __forceinline__ float bf2f(bf16_t v) { return __uint_as_float(((unsigned)v) << 16); }
typedef __bf16 bf16x2_t __attribute__((ext_vector_type(2)));
__device__ __forceinline__ unsigned cvt_pk_bf16(float lo, float hi) { const f32x2 v = {lo, hi}; const bf16x2_t b = __builtin_convertvector(v, bf16x2_t); return __builtin_bit_cast(unsigned, b); }
__device__ __forceinline__ bf16_t f2bf(float f) { return (bf16_t)(cvt_pk_bf16(f, 0.f) & 0xffffu); }
__device__ __forceinline__ u32x4 pack8(const f32x4 a, const f32x4 b) { u32x4 w; w.x = cvt_pk_bf16(a[0], a[1]); w.y = cvt_pk_bf16(a[2], a[3]); w.z = cvt_pk_bf16(b[0], b[1]); w.w = cvt_pk_bf16(b[2], b[3]); return w; }
__device__ __forceinline__ void unpack8(const u32x4 w, f32x4& a, f32x4& b) { a[0] = bf_lo(w.x); a[1] = bf_hi(w.x); a[2] = bf_lo(w.y); a[3] = bf_hi(w.y); b[0] = bf_lo(w.z); b[1] = bf_hi(w.z); b[2] = bf_lo(w.w); b[3] = bf_hi(w.w); }
__device__ __forceinline__ float sigm(float x) { return __builtin_amdgcn_rcpf(1.0f + __builtin_amdgcn_exp2f(-1.4426950408889634f * x)); }
__device__ __forceinline__ int opaque_tid() { int t = threadIdx.x; asm volatile("" : "+v"(t)); return t; }
__device__ __forceinline__ float wave_sum(float v) {
#pragma unroll
    for (int o = 1; o < 64; o <<= 1) v += __shfl_xor(v, o);
    return v;
}
__device__ __forceinline__ int map_in(int r) {
    const int t = r >> 8, j = r & 255, h = j >> 7, jj = j & 127;
    if (t < 4) return h * 512 + 128 * t + jj;
    if (t < 6) return 1024 + 256 * (t - 4) + j;
    if (t < 10) return (h ? 2048 : 1536) + 128 * (t - 6) + jj;
    return 2560 + 256 * (t - 10) + j;
}
__device__ __forceinline__ int map_gu(int r) { const int t = r >> 8, j = r & 255, h = j >> 7, jj = j & 127; return h * DFF + 128 * t + jj; }

namespace pg8 {
constexpr int BM = 256, BK = 64, HALF = 128, HTB = HALF * BK * 2, STAGE_BYTES = 8 * HTB, NXCD = 8, WGM = 4;
__device__ __forceinline__ int lds_byte(int r, int c) { const int st = (r >> 4) * 2 + (c >> 5), rr = r & 15, cc = c & 31, ob = rr * 64 + cc * 2; return st * 1024 + (ob ^ (((ob >> 9) & 1) << 5)); }
__device__ __forceinline__ void stage_rc(int b, int& R, int& C) { const int st = b / 1024, sb = b % 1024, swz = sb ^ (((sb >> 9) & 1) << 5); R = (st >> 1) * 16 + swz / 64; C = (st & 1) * 32 + (swz % 64) / 2; }
__device__ __forceinline__ int perm32(int rho) { const int n = rho >> 4, i = rho & 15; return 8 * (i >> 2) + 4 * n + (i & 3); }

struct Unit { int pm, pn, sel; };
struct Gemm { const unsigned char* arena; unsigned offA0, offA1; const bf16_t *B0, *B1; int K; };

struct Order {
    int nM, nN, nwg, G, c, dual;
    __device__ void init(int M_, int N_, int G_, int c_, int dual_) { nM = M_ / BM; nN = N_ / BM; nwg = nM * nN; G = G_; c = c_; dual = dual_; }
    __device__ bool next(int i, Unit& u) const {
        const int ii = dual ? (i >> 1) : i;
        const long L = (long)ii * G + c; if (L >= nwg) return false;
        int wgid = (int)L; { const int q = nwg / NXCD, r = nwg % NXCD, xcd = wgid % NXCD, off = wgid / NXCD; wgid = (xcd < r ? xcd * (q + 1) : r * (q + 1) + (xcd - r) * q) + off; }
        const int nig = WGM * nN, gid = wgid / nig, fm = gid * WGM, gsz = (nM - fm) < WGM ? (nM - fm) : WGM;
        u.pm = fm + ((wgid % nig) % gsz); u.pn = (wgid % nig) / gsz; u.sel = dual ? (i & 1) : 0; return true;
    }
};

template <class Epi>
__device__ __forceinline__ void gemm_phase(LAS unsigned char* lds, const Gemm g, const Order& S, const Epi& E) {
    const int tid = opaque_tid(), wid = __builtin_amdgcn_readfirstlane(tid >> 6), lane = tid & 63, wr = wid >> 2, wc = wid & 3, fr = lane & 15, fq = lane >> 4;
    const int K = g.K, nt = K / BK;
    unsigned voffA[2], voffB[2];
#pragma unroll
    for (int i = 0; i < 2; ++i) { int R, C; stage_rc(tid * 16 + i * 8192, R, C); const int Rb = (R & ~31) + perm32(R & 31);
        voffA[i] = (unsigned)(R * K + C) * 2u; voffB[i] = (unsigned)(Rb * K + C) * 2u; }
    const size_t kstep = (size_t)(BK * 2);
    const size_t hstep = (size_t)HALF * K * 2;
    const size_t tstep = 2 * hstep;
    const unsigned ldsw = (unsigned)wid * 1024u;
    const int aoff = lds_byte(wr * 64 + fr, fq * 8), boff = lds_byte(wc * 32 + fr, fq * 8);
#define PG8_SA(b, h) (((b) * 2 + (h)) * HTB)
#define PG8_SB(b, h) ((4 + (b) * 2 + (h)) * HTB)
#define PG8_STAGE(bufoff, gbase, voff) do { _Pragma("unroll") for (int _i = 0; _i < 2; ++_i) \
        __builtin_amdgcn_global_load_lds((const unsigned*)((const char*)(gbase) + (voff)[_i]), (LAS unsigned*)(lds + (bufoff) + ldsw + _i * 8192), 16, 0, 0); } while (0)
#define PG8_LDA(dst, b, h) do { _Pragma("unroll") for (int m = 0; m < 4; ++m) _Pragma("unroll") for (int k = 0; k < 2; ++k) dst[m][k] = *(const LAS bf16x8*)(lds + PG8_SA(b, h) + aoff + m * 2048 + k * 1024); } while (0)
#define PG8_LDB(dst, b, h) do { _Pragma("unroll") for (int n = 0; n < 2; ++n) _Pragma("unroll") for (int k = 0; k < 2; ++k) dst[n][k] = *(const LAS bf16x8*)(lds + PG8_SB(b, h) + boff + n * 2048 + k * 1024); } while (0)
#define PG8_MMA(ai, bj, At, Bt) do { __builtin_amdgcn_s_setprio(1); _Pragma("unroll") for (int m = 0; m < 4; ++m) _Pragma("unroll") for (int n = 0; n < 2; ++n) _Pragma("unroll") for (int k = 0; k < 2; ++k) \
        acc[ai][bj][m][n] = __builtin_amdgcn_mfma_f32_16x16x32_bf16(Bt[n][k], At[m][k], acc[ai][bj][m][n], 0, 0, 0); __builtin_amdgcn_s_setprio(0); } while (0)
#define PG8_WAIT_V(n) asm volatile("s_waitcnt vmcnt(" #n ")" ::: "memory")
#define PG8_WAIT_L(n) asm volatile("s_waitcnt lgkmcnt(" #n ")" ::: "memory")
#define PG8_BAR __builtin_amdgcn_s_barrier()
#define PG8_SCHED __builtin_amdgcn_sched_barrier(0)
    Unit cur, nxt; int ui = 0;
    if (!S.next(0, cur)) return;
    f32x4 acc[2][2][4][2];
#pragma unroll
    for (int a = 0; a < 2; ++a)
#pragma unroll
        for (int b = 0; b < 2; ++b)
#pragma unroll
            for (int m = 0; m < 4; ++m)
#pragma unroll
                for (int n = 0; n < 2; ++n) acc[a][b][m][n] = (f32x4){0.f, 0.f, 0.f, 0.f};
    bf16x8 At[4][2], B0[2][2], B1[2][2];
    const char* cA = (const char*)g.arena + (size_t)(cur.pm >> 3) * ARENA + (cur.sel ? g.offA1 : g.offA0) + (size_t)(cur.pm & 7) * tstep; const char* cB = (const char*)(cur.sel ? g.B1 : g.B0) + (size_t)cur.pn * tstep;
    PG8_STAGE(PG8_SB(0, 0), cB, voffB); PG8_STAGE(PG8_SB(0, 1), cB + hstep, voffB); PG8_STAGE(PG8_SA(0, 0), cA, voffA); PG8_STAGE(PG8_SA(0, 1), cA + hstep, voffA);
    if (wr == 1) PG8_BAR;
    PG8_WAIT_V(2); PG8_BAR;
    PG8_STAGE(PG8_SB(1, 0), cB + kstep, voffB); PG8_STAGE(PG8_SA(1, 0), cA + kstep, voffA); PG8_STAGE(PG8_SB(1, 1), cB + hstep + kstep, voffB);
    PG8_WAIT_V(6); PG8_BAR;
    for (;;) {
        const bool has_next = S.next(ui + 1, nxt);
        const char* nA = has_next ? (const char*)g.arena + (size_t)(nxt.pm >> 3) * ARENA + (nxt.sel ? g.offA1 : g.offA0) + (size_t)(nxt.pm & 7) * tstep : cA; const char* nB = has_next ? (const char*)(nxt.sel ? g.B1 : g.B0) + (size_t)nxt.pn * tstep : cB;
        for (int t = 0; t < nt; t += 2) {
            const bool last = (t == nt - 2);
            const char* a1 = cA + (size_t)(t + 1) * kstep;
            const char* a2 = last ? nA : cA + (size_t)(t + 2) * kstep; const char* b2 = last ? nB : cB + (size_t)(t + 2) * kstep;
            const char* a3 = a2 + kstep; const char* b3 = b2 + kstep;
            PG8_LDB(B0, 0, 0); PG8_LDB(B1, 0, 1); PG8_SCHED; PG8_LDA(At, 0, 0); PG8_STAGE(PG8_SA(1, 1), a1 + hstep, voffA);
            PG8_WAIT_V(8); PG8_WAIT_L(0); PG8_BAR; PG8_MMA(0, 0, At, B0); PG8_MMA(0, 1, At, B1); PG8_BAR; PG8_SCHED;
            PG8_LDA(At, 0, 1); PG8_STAGE(PG8_SB(0, 0), b2, voffB); PG8_STAGE(PG8_SB(0, 1), b2 + hstep, voffB); PG8_STAGE(PG8_SA(0, 0), a2, voffA);
            PG8_WAIT_V(8); PG8_WAIT_L(0); PG8_BAR; PG8_MMA(1, 0, At, B0); PG8_MMA(1, 1, At, B1); PG8_BAR; PG8_SCHED;
            PG8_LDB(B0, 1, 0); PG8_LDB(B1, 1, 1); PG8_SCHED; PG8_LDA(At, 1, 0); PG8_STAGE(PG8_SA(0, 1), a2 + hstep, voffA);
            PG8_WAIT_V(8); PG8_WAIT_L(0); PG8_BAR; PG8_MMA(0, 0, At, B0); PG8_MMA(0, 1, At, B1); PG8_BAR; PG8_SCHED;
            PG8_LDA(At, 1, 1); PG8_STAGE(PG8_SB(1, 0), b3, voffB); PG8_STAGE(PG8_SB(1, 1), b3 + hstep, voffB); PG8_STAGE(PG8_SA(1, 0), a3, voffA);
            PG8_WAIT_V(8); PG8_WAIT_L(0); PG8_BAR; PG8_MMA(1, 0, At, B0); PG8_MMA(1, 1, At, B1); PG8_BAR; PG8_SCHED;
        }
        if (wr == 0) PG8_BAR;
        if constexpr (Epi::TRANSFORM) { if (cur.sel == 0) E.transform(acc, cur, wr, wc, fr, fq); else E(acc, cur, wr, wc, fr, fq); }
        else if constexpr (!Epi::AFTER_DRAIN) E(acc, cur, wr, wc, fr, fq);
        if (!has_next) break;
        if (!(Epi::TRANSFORM && cur.sel == 0))
#pragma unroll
        for (int a = 0; a < 2; ++a)
#pragma unroll
            for (int b = 0; b < 2; ++b)
#pragma unroll
                for (int m = 0; m < 4; ++m)
#pragma unroll
                    for (int n = 0; n < 2; ++n) acc[a][b][m][n] = (f32x4){0.f, 0.f, 0.f, 0.f};
        cur = nxt; cA = nA; cB = nB; ++ui;
        if (wr == 1) PG8_BAR;
    }
    PG8_WAIT_V(0);
    PG8_BAR;
    if constexpr (Epi::AFTER_DRAIN) E.fused(acc, cur, wr, wc, fr, fq, lds, wid, lane);
#undef PG8_SA
#undef PG8_SB
#undef PG8_STAGE
#undef PG8_LDA
#undef PG8_LDB
#undef PG8_MMA
#undef PG8_WAIT_V
#undef PG8_WAIT_L
#undef PG8_BAR
#undef PG8_SCHED
}
}

typedef const f32x4 (&AccRef)[2][2][4][2];
#define EPI_ROWS const int rl0 = (u.pm & 7) * 256 + wr * 64 + fr; unsigned char* const ab = arena + (size_t)(u.pm >> 3) * ARENA
struct EpiIn {
    static constexpr bool AFTER_DRAIN = false, TRANSFORM = false;
    unsigned char* arena; const float *b_glu, *b_gate;
    __device__ __forceinline__ void operator()(AccRef acc, const pg8::Unit& u, int wr, int wc, int fr, int fq) const {
        EPI_ROWS; const int t = u.pn, cw = wc * 32 + fq * 8;
        if (t < 4) {
            bf16_t* U = (bf16_t*)(ab + AO_U); const int cA = 128 * t + cw; f32x4 ba[2], bb[2];
#pragma unroll
            for (int n = 0; n < 2; ++n) { ba[n] = *(const f32x4*)(b_glu + cA + 4 * n); bb[n] = *(const f32x4*)(b_glu + 512 + cA + 4 * n); }
#pragma unroll
            for (int ai = 0; ai < 2; ++ai)
#pragma unroll
                for (int m = 0; m < 4; ++m) { f32x4 r[2];
#pragma unroll
                    for (int n = 0; n < 2; ++n) { const f32x4 a = acc[ai][0][m][n] + ba[n], b = acc[ai][1][m][n] + bb[n];
#pragma unroll
                        for (int j = 0; j < 4; ++j) r[n][j] = a[j] * sigm(b[j]); }
                    *(u32x4*)(U + (size_t)(rl0 + ai * 128 + m * 16) * DC + cA) = pack8(r[0], r[1]); }
        } else if (t < 6) {
            bf16_t* GB = (bf16_t*)(ab + AO_GB); const int c0 = 256 * (t - 4) + cw;
#pragma unroll
            for (int ai = 0; ai < 2; ++ai)
#pragma unroll
                for (int m = 0; m < 4; ++m)
#pragma unroll
                    for (int bj = 0; bj < 2; ++bj) *(u32x4*)(GB + (size_t)(rl0 + ai * 128 + m * 16) * DC + c0 + 128 * bj) = pack8(acc[ai][bj][m][0], acc[ai][bj][m][1]);
        } else if (t < 10) {
            bf16_t* GCV = (bf16_t*)(ab + AO_GCV); const int cA = 128 * (t - 6) + cw;
#pragma unroll
            for (int ai = 0; ai < 2; ++ai)
#pragma unroll
                for (int m = 0; m < 4; ++m)
                    *(u32x4*)(GCV + (size_t)(rl0 + ai * 128 + m * 16) * DC + cA) = pack8(acc[ai][0][m][0] * acc[ai][1][m][0], acc[ai][0][m][1] * acc[ai][1][m][1]);
        } else {
            unsigned char* GATES = ab + AO_GATES; const int c0 = 256 * (t - 10) + cw, cg16 = 256 * (t - 10) + wc * 64 + fq * 16; f32x4 bv[2][2]; const float qmin = (t >= 14) ? 1.0f : 0.0f;
#pragma unroll
            for (int bj = 0; bj < 2; ++bj)
#pragma unroll
                for (int n = 0; n < 2; ++n) bv[bj][n] = *(const f32x4*)(b_gate + c0 + 128 * bj + 4 * n);
#pragma unroll
            for (int ai = 0; ai < 2; ++ai)
#pragma unroll
                for (int m = 0; m < 4; ++m)
                    { u32x4 w4;
#pragma unroll
                      for (int bj = 0; bj < 2; ++bj)
#pragma unroll
                        for (int n = 0; n < 2; ++n) { const f32x4 a = acc[ai][bj][m][n] + bv[bj][n]; unsigned q = 0u;
#pragma unroll
                            for (int j = 0; j < 4; ++j) q = __builtin_amdgcn_cvt_pk_u8_f32(fmaxf(255.0f * sigm(a[j]), qmin), j, q);
                            w4[bj * 2 + n] = q; }
                      *(u32x4*)(GATES + (size_t)(rl0 + ai * 128 + m * 16) * 2048 + cg16) = w4; }
        }
    }
};
struct EpiDual {
    static constexpr bool AFTER_DRAIN = false, TRANSFORM = true;
    unsigned char* arena; const float* b_out;
    __device__ __forceinline__ void transform(f32x4 (&acc)[2][2][4][2], const pg8::Unit& u, int wr, int wc, int fr, int fq) const {
        EPI_ROWS; const int c0 = 256 * u.pn + wc * 32 + fq * 8, cg16 = 256 * u.pn + wc * 64 + fq * 16; const unsigned char* GA = ab + AO_GATES; f32x4 bv[2][2];
#pragma unroll
        for (int bj = 0; bj < 2; ++bj)
#pragma unroll
            for (int n = 0; n < 2; ++n) bv[bj][n] = *(const f32x4*)(b_out + c0 + 128 * bj + 4 * n);
        u32x4 ac = *(const u32x4*)(GA + (size_t)rl0 * 2048 + cg16), bc = *(const u32x4*)(GA + (size_t)rl0 * 2048 + 1024 + cg16), an, bn;
#pragma unroll
        for (int g = 0; g < 8; ++g) { const int ai = g >> 2, m = g & 3;
            if (g < 7) { const size_t rown = (size_t)(rl0 + ((g + 1) >> 2) * 128 + ((g + 1) & 3) * 16);
                an = *(const u32x4*)(GA + rown * 2048 + cg16); bn = *(const u32x4*)(GA + rown * 2048 + 1024 + cg16); }
#pragma unroll
            for (int bj = 0; bj < 2; ++bj)
#pragma unroll
                for (int n = 0; n < 2; ++n)
#pragma unroll
                    for (int j = 0; j < 4; ++j) {
                        const float r = (float)((ac[bj * 2 + n] >> (8 * j)) & 0xffu) * __builtin_amdgcn_rcpf((float)((bc[bj * 2 + n] >> (8 * j)) & 0xffu));
                        acc[ai][bj][m][n][j] = (acc[ai][bj][m][n][j] + bv[bj][n][j]) * r; }
            ac = an; bc = bn;
            asm volatile("" ::: "memory"); }
    }
    __device__ __forceinline__ void operator()(AccRef acc, const pg8::Unit& u, int wr, int wc, int fr, int fq) const {
        EPI_ROWS; const int c0 = 256 * u.pn + wc * 32 + fq * 8, cg16 = 256 * u.pn + wc * 64 + fq * 16; bf16_t* MIX = (bf16_t*)(ab + AO_MIX); const unsigned char* GB = ab + AO_GATES + 1024;
        u32x4 bc = *(const u32x4*)(GB + (size_t)rl0 * 2048 + cg16), bn;
#pragma unroll
        for (int g = 0; g < 8; ++g) { const int ai = g >> 2, m = g & 3;
            if (g < 7) { const size_t rown = (size_t)(rl0 + ((g + 1) >> 2) * 128 + ((g + 1) & 3) * 16); bn = *(const u32x4*)(GB + rown * 2048 + cg16); }
            const size_t row = (size_t)(rl0 + ai * 128 + m * 16);
#pragma unroll
            for (int bj = 0; bj < 2; ++bj) { f32x4 g0, g1;
#pragma unroll
                for (int j = 0; j < 4; ++j) { g0[j] = (float)((bc[bj * 2] >> (8 * j)) & 0xffu) * (1.0f / 255.0f); g1[j] = (float)((bc[bj * 2 + 1] >> (8 * j)) & 0xffu) * (1.0f / 255.0f); }
                *(u32x4*)(MIX + row * D + c0 + 128 * bj) = pack8(acc[ai][bj][m][0] * g0, acc[ai][bj][m][1] * g1); }
            bc = bn;
            asm volatile("" ::: "memory"); }
    }
};
template <bool FROM_X> struct EpiRes {
    static constexpr bool AFTER_DRAIN = false, TRANSFORM = false;
    unsigned char* arena; const float* x; const float* gt;
    __device__ __forceinline__ void operator()(AccRef acc, const pg8::Unit& u, int wr, int wc, int fr, int fq) const {
        EPI_ROWS; const int c0 = 256 * u.pn + wc * 32 + fq * 8, b = u.pm >> 3; f32x4 gv[2][2];
        float* xout = (float*)(ab + AO_X1); const float* xin = FROM_X ? x + (size_t)b * SEQ * D : (const float*)xout;
#pragma unroll
        for (int bj = 0; bj < 2; ++bj)
#pragma unroll
            for (int n = 0; n < 2; ++n) gv[bj][n] = *(const f32x4*)(gt + (size_t)b * MSTR + c0 + 128 * bj + 4 * n);
        f32x4 cur[2][2], nxt[2][2];
        { const size_t off = (size_t)rl0 * D + c0;
#pragma unroll
          for (int bj = 0; bj < 2; ++bj)
#pragma unroll
              for (int n = 0; n < 2; ++n) cur[bj][n] = *(const f32x4*)(xin + off + 128 * bj + 4 * n); }
#pragma unroll
        for (int g = 0; g < 8; ++g) { const int ai = g >> 2, m = g & 3;
            if (g < 7) { const size_t offn = (size_t)(rl0 + ((g + 1) >> 2) * 128 + ((g + 1) & 3) * 16) * D + c0;
#pragma unroll
                for (int bj = 0; bj < 2; ++bj)
#pragma unroll
                    for (int n = 0; n < 2; ++n) nxt[bj][n] = *(const f32x4*)(xin + offn + 128 * bj + 4 * n); }
            const size_t off = (size_t)(rl0 + ai * 128 + m * 16) * D + c0;
#pragma unroll
            for (int bj = 0; bj < 2; ++bj)
#pragma unroll
                for (int n = 0; n < 2; ++n) *(f32x4*)(xout + off + 128 * bj + 4 * n) = cur[bj][n] + gv[bj][n] * acc[ai][bj][m][n];
#pragma unroll
            for (int bj = 0; bj < 2; ++bj)
#pragma unroll
                for (int n = 0; n < 2; ++n) cur[bj][n] = nxt[bj][n];
            asm volatile("" ::: "memory"); }
    }
};
struct EpiFinal {
    static constexpr bool AFTER_DRAIN = true, TRANSFORM = false;
    unsigned char* arena; const float* gt; const float* fg; float* out; float* xch; unsigned* cnt;
    __device__ __forceinline__ void fused(f32x4 (&acc)[2][2][4][2], const pg8::Unit& u, int wr, int wc, int fr, int fq, LAS unsigned char* lds, int wid, int lane) const {
        EPI_ROWS; const int c0 = 256 * u.pn + wc * 32 + fq * 8, b = u.pm >> 3; f32x4 gv[2][2];
        const bf16_t* xin = (const bf16_t*)(ab + AO_X1);
#pragma unroll
        for (int bj = 0; bj < 2; ++bj)
#pragma unroll
            for (int n = 0; n < 2; ++n) gv[bj][n] = *(const f32x4*)(gt + (size_t)b * MSTR + c0 + 128 * bj + 4 * n);
        u32x4 cur[2], nxt[2];
        { const size_t off = (size_t)rl0 * D + c0;
#pragma unroll
          for (int bj = 0; bj < 2; ++bj) cur[bj] = *(const u32x4*)(xin + off + 128 * bj); }
        LAS float* P = (LAS float*)lds; LAS float* S = (LAS float*)(lds + 4096);
#pragma unroll
        for (int g = 0; g < 8; ++g) { const int ai = g >> 2, m = g & 3;
            if (g < 7) { const size_t offn = (size_t)(rl0 + ((g + 1) >> 2) * 128 + ((g + 1) & 3) * 16) * D + c0;
#pragma unroll
                for (int bj = 0; bj < 2; ++bj) nxt[bj] = *(const u32x4*)(xin + offn + 128 * bj); }
            float sq = 0.f;
#pragma unroll
            for (int bj = 0; bj < 2; ++bj) { f32x4 xc[2]; unpack8(cur[bj], xc[0], xc[1]);
#pragma unroll
                for (int n = 0; n < 2; ++n) { const f32x4 v = xc[n] + gv[bj][n] * acc[ai][bj][m][n]; acc[ai][bj][m][n] = v; sq += (v[0] * v[0] + v[1] * v[1]) + (v[2] * v[2] + v[3] * v[3]); } }
            sq += __shfl_xor(sq, 16); sq += __shfl_xor(sq, 32);
            if (fq == 0) P[(ai * 128 + wr * 64 + m * 16 + fr) * 4 + wc] = sq;
#pragma unroll
            for (int bj = 0; bj < 2; ++bj) cur[bj] = nxt[bj]; }
        asm volatile("s_waitcnt lgkmcnt(0)" ::: "memory"); __builtin_amdgcn_s_barrier(); asm volatile("" ::: "memory");
        const int tid = wid * 64 + lane;
        if (tid < 256) { const float bp = (P[tid * 4] + P[tid * 4 + 1]) + (P[tid * 4 + 2] + P[tid * 4 + 3]);
            __hip_atomic_store(xch + ((size_t)u.pm * 256 + tid) * 4 + u.pn, bp, __ATOMIC_RELAXED, __HIP_MEMORY_SCOPE_AGENT); }
        asm volatile("s_waitcnt vmcnt(0)" ::: "memory");
        if (tid < 256 && lane == 0) __hip_atomic_fetch_add(cnt + u.pm * 16, 1u, __ATOMIC_RELAXED, __HIP_MEMORY_SCOPE_AGENT);
        if (wid == 0) { unsigned spins = 0;
            while ((unsigned)__builtin_amdgcn_readfirstlane(__hip_atomic_load(cnt + u.pm * 16, __ATOMIC_RELAXED, __HIP_MEMORY_SCOPE_AGENT)) < 16u) { __builtin_amdgcn_s_sleep(2); if (++spins > (1u << 20)) break; }
            __builtin_amdgcn_fence(__ATOMIC_ACQUIRE, "agent"); asm volatile("s_waitcnt vmcnt(0)" ::: "memory"); }
        asm volatile("s_waitcnt vmcnt(0) lgkmcnt(0)" ::: "memory"); __builtin_amdgcn_s_barrier(); asm volatile("" ::: "memory");
        if (tid < 256) { const float* xr = xch + ((size_t)u.pm * 256 + tid) * 4;
            const float t = (__hip_atomic_load(xr, __ATOMIC_RELAXED, __HIP_MEMORY_SCOPE_AGENT) + __hip_atomic_load(xr + 1, __ATOMIC_RELAXED, __HIP_MEMORY_SCOPE_AGENT))
                          + (__hip_atomic_load(xr + 2, __ATOMIC_RELAXED, __HIP_MEMORY_SCOPE_AGENT) + __hip_atomic_load(xr + 3, __ATOMIC_RELAXED, __HIP_MEMORY_SCOPE_AGENT));
            S[tid] = rsqrtf(t * (1.f / D) + RMS_EPS); }
        asm volatile("s_waitcnt vmcnt(0) lgkmcnt(0)" ::: "memory"); __builtin_amdgcn_s_barrier(); asm volatile("" ::: "memory");
        f32x4 fgv[2][2];
#pragma unroll
        for (int bj = 0; bj < 2; ++bj)
#pragma unroll
            for (int n = 0; n < 2; ++n) fgv[bj][n] = *(const f32x4*)(fg + c0 + 128 * bj + 4 * n);
#pragma unroll
        for (int ai = 0; ai < 2; ++ai)
#pragma unroll
            for (int m = 0; m < 4; ++m) { const int lr = ai * 128 + wr * 64 + m * 16 + fr; const float r = S[lr]; float* orow = out + (size_t)(u.pm * 256 + lr) * D + c0;
#pragma unroll
                for (int bj = 0; bj < 2; ++bj)
#pragma unroll
                    for (int n = 0; n < 2; ++n) *(f32x4*)(orow + 128 * bj + 4 * n) = acc[ai][bj][m][n] * r * fgv[bj][n]; }
    }
};
struct EpiResNorm {
    static constexpr bool AFTER_DRAIN = true, TRANSFORM = false;
    unsigned char* arena; const float* x; const float* mod; const float* g2; float* xch; unsigned* cnt;
    __device__ __forceinline__ void fused(f32x4 (&acc)[2][2][4][2], const pg8::Unit& u, int wr, int wc, int fr, int fq, LAS unsigned char* lds, int wid, int lane) const {
        EPI_ROWS; const int c0 = 256 * u.pn + wc * 32 + fq * 8, b = u.pm >> 3; const float* mb = mod + (size_t)b * MSTR;
        const float* xin = x + (size_t)b * SEQ * D; bf16_t* x1 = (bf16_t*)(ab + AO_X1); bf16_t* H2 = (bf16_t*)(ab + AO_A1);
        LAS float* P = (LAS float*)lds; LAS float* S = (LAS float*)(lds + 4096);
        { f32x4 gv[2][2], cur[2][2], nxt[2][2];
#pragma unroll
          for (int bj = 0; bj < 2; ++bj)
#pragma unroll
              for (int n = 0; n < 2; ++n) gv[bj][n] = *(const f32x4*)(mb + MO_GT1 + c0 + 128 * bj + 4 * n);
          { const size_t off = (size_t)rl0 * D + c0;
#pragma unroll
            for (int bj = 0; bj < 2; ++bj)
#pragma unroll
                for (int n = 0; n < 2; ++n) cur[bj][n] = *(const f32x4*)(xin + off + 128 * bj + 4 * n); }
#pragma unroll
          for (int g = 0; g < 8; ++g) { const int ai = g >> 2, m = g & 3;
              if (g < 7) { const size_t offn = (size_t)(rl0 + ((g + 1) >> 2) * 128 + ((g + 1) & 3) * 16) * D + c0;
#pragma unroll
                  for (int bj = 0; bj < 2; ++bj)
#pragma unroll
                      for (int n = 0; n < 2; ++n) nxt[bj][n] = *(const f32x4*)(xin + offn + 128 * bj + 4 * n); }
              float sq = 0.f;
#pragma unroll
              for (int bj = 0; bj < 2; ++bj)
#pragma unroll
                  for (int n = 0; n < 2; ++n) { const f32x4 v = cur[bj][n] + gv[bj][n] * acc[ai][bj][m][n]; acc[ai][bj][m][n] = v; sq += (v[0] * v[0] + v[1] * v[1]) + (v[2] * v[2] + v[3] * v[3]); }
              sq += __shfl_xor(sq, 16); sq += __shfl_xor(sq, 32);
              if (fq == 0) P[(ai * 128 + wr * 64 + m * 16 + fr) * 4 + wc] = sq;
#pragma unroll
              for (int bj = 0; bj < 2; ++bj)
#pragma unroll
                  for (int n = 0; n < 2; ++n) cur[bj][n] = nxt[bj][n]; } }
        asm volatile("s_waitcnt lgkmcnt(0)" ::: "memory"); __builtin_amdgcn_s_barrier(); asm volatile("" ::: "memory");
        const int tid = wid * 64 + lane;
        if (tid < 256) { const float bp = (P[tid * 4] + P[tid * 4 + 1]) + (P[tid * 4 + 2] + P[tid * 4 + 3]);
            __hip_atomic_store(xch + ((size_t)u.pm * 256 + tid) * 4 + u.pn, bp, __ATOMIC_RELAXED, __HIP_MEMORY_SCOPE_AGENT); }
        asm volatile("s_waitcnt vmcnt(0)" ::: "memory");
        if (tid < 256 && lane == 0) __hip_atomic_fetch_add(cnt + u.pm * 16, 1u, __ATOMIC_RELAXED, __HIP_MEMORY_SCOPE_AGENT);
        if (wid == 0) { unsigned spins = 0;
            while ((unsigned)__builtin_amdgcn_readfirstlane(__hip_atomic_load(cnt + u.pm * 16, __ATOMIC_RELAXED, __HIP_MEMORY_SCOPE_AGENT)) < 16u) { __builtin_amdgcn_s_sleep(2); if (++spins > (1u << 20)) break; }
            __builtin_amdgcn_fence(__ATOMIC_ACQUIRE, "agent"); asm volatile("s_waitcnt vmcnt(0)" ::: "memory"); }
        asm volatile("s_waitcnt vmcnt(0) lgkmcnt(0)" ::: "memory"); __builtin_amdgcn_s_barrier(); asm volatile("" ::: "memory");
        if (tid < 256) { const float* xr = xch + ((size_t)u.pm * 256 + tid) * 4;
            const float t = (__hip_atomic_load(xr, __ATOMIC_RELAXED, __HIP_MEMORY_SCOPE_AGENT) + __hip_atomic_load(xr + 1, __ATOMIC_RELAXED, __HIP_MEMORY_SCOPE_AGENT))
                          + (__hip_atomic_load(xr + 2, __ATOMIC_RELAXED, __HIP_MEMORY_SCOPE_AGENT) + __hip_atomic_load(xr + 3, __ATOMIC_RELAXED, __HIP_MEMORY_SCOPE_AGENT));
            S[tid] = rsqrtf(t * (1.f / D) + RMS_EPS); }
        asm volatile("s_waitcnt vmcnt(0) lgkmcnt(0)" ::: "memory"); __builtin_amdgcn_s_barrier(); asm volatile("" ::: "memory");
        f32x4 mul[2][2], sh[2][2];
#pragma unroll
        for (int bj = 0; bj < 2; ++bj)
#pragma unroll
            for (int n = 0; n < 2; ++n) { const int col = c0 + 128 * bj + 4 * n; const f32x4 gg = *(const f32x4*)(g2 + col), sc = *(const f32x4*)(mb + MO_SC2 + col);
                sh[bj][n] = *(const f32x4*)(mb + MO_SH2 + col); mul[bj][n] = gg * (sc + 1.0f); }
#pragma unroll
        for (int ai = 0; ai < 2; ++ai)
#pragma unroll
            for (int m = 0; m < 4; ++m) { const int lr = ai * 128 + wr * 64 + m * 16 + fr; const float r = S[lr]; const size_t off = (size_t)(rl0 + ai * 128 + m * 16) * D + c0;
#pragma unroll
                for (int bj = 0; bj < 2; ++bj) {
                    *(u32x4*)(x1 + off + 128 * bj) = pack8(acc[ai][bj][m][0], acc[ai][bj][m][1]);
                    *(u32x4*)(H2 + off + 128 * bj) = pack8(acc[ai][bj][m][0] * r * mul[bj][0] + sh[bj][0], acc[ai][bj][m][1] * r * mul[bj][1] + sh[bj][1]); } }
    }
};
struct EpiGU {
    static constexpr bool AFTER_DRAIN = false, TRANSFORM = false;
    unsigned char* arena;
    __device__ __forceinline__ void operator()(AccRef acc, const pg8::Unit& u, int wr, int wc, int fr, int fq) const {
        EPI_ROWS; const int cA = 128 * u.pn + wc * 32 + fq * 8; bf16_t* ACT = (bf16_t*)(ab + AO_ACT);
#pragma unroll
        for (int ai = 0; ai < 2; ++ai)
#pragma unroll
            for (int m = 0; m < 4; ++m) { f32x4 r[2];
#pragma unroll
                for (int n = 0; n < 2; ++n) { const f32x4 a = acc[ai][0][m][n], b = acc[ai][1][m][n];
#pragma unroll
                    for (int j = 0; j < 4; ++j) r[n][j] = a[j] * sigm(a[j]) * b[j]; }
                *(u32x4*)(ACT + (size_t)(rl0 + ai * 128 + m * 16) * DFF + cA) = pack8(r[0], r[1]); }
    }
};

__device__ __forceinline__ void p0_mod(const Args& a, float* mod, LAS unsigned char* lds, int item, int tid, int lane, int wave) {
    LAS float* cs = (LAS float*)lds; LAS float* red = (LAS float*)(lds + 32768);
    for (int i = tid; i < NB * D; i += 512) { const int b = i >> 10, k = i & 1023; const float v = a.c[i]; cs[k * 8 + b] = v * sigm(v); }
    __syncthreads();
    const int jl = lane & 31, j = item * 32 + jl, kg = wave * 2 + (lane >> 5);
    float s0 = 0.f, s1 = 0.f, s2 = 0.f, s3 = 0.f, s4 = 0.f, s5 = 0.f, s6 = 0.f, s7 = 0.f;
#pragma unroll 16
    for (int kk = 0; kk < 64; ++kk) { const int k = kg * 64 + kk; const float w = a.w_ada[(size_t)k * NMOD + j];
        const f32x4 c0 = *(const LAS f32x4*)(cs + k * 8), c1 = *(const LAS f32x4*)(cs + k * 8 + 4);
        s0 += w * c0[0]; s1 += w * c0[1]; s2 += w * c0[2]; s3 += w * c0[3]; s4 += w * c1[0]; s5 += w * c1[1]; s6 += w * c1[2]; s7 += w * c1[3]; }
    red[(kg * 8 + 0) * 32 + jl] = s0; red[(kg * 8 + 1) * 32 + jl] = s1; red[(kg * 8 + 2) * 32 + jl] = s2; red[(kg * 8 + 3) * 32 + jl] = s3;
    red[(kg * 8 + 4) * 32 + jl] = s4; red[(kg * 8 + 5) * 32 + jl] = s5; red[(kg * 8 + 6) * 32 + jl] = s6; red[(kg * 8 + 7) * 32 + jl] = s7;
    __syncthreads();
    if (tid < 256) { const int b = tid >> 5, jj = tid & 31; float s = 0.f;
#pragma unroll
        for (int g = 0; g < 16; ++g) s += red[(g * 8 + b) * 32 + jj];
        mod[(size_t)b * MSTR + item * 32 + jj] = s + a.b_ada[item * 32 + jj]; }
    __syncthreads();
}
__device__ __forceinline__ void p0_mod_ksplit(const Args& a, float* part, LAS unsigned char* lds, int item, int tid, int lane, int wave) {
    LAS float* cs = (LAS float*)lds; LAS float* red = (LAS float*)(lds + 4096);
    const int g = item >> 3, kc = item & 7;
    for (int i = tid; i < 128 * NB; i += 512) { const int b = i >> 7, k = i & 127; const float v = a.c[b * D + kc * 128 + k]; cs[k * 8 + b] = v * sigm(v); }
    f32x4 wv[16];
#pragma unroll
    for (int i = 0; i < 16; ++i) wv[i] = *(const f32x4*)(a.w_ada + (size_t)(kc * 128 + wave * 16 + i) * NMOD + g * 256 + 4 * lane);
    __syncthreads();
    f32x4 acc[8];
#pragma unroll
    for (int b = 0; b < 8; ++b) acc[b] = (f32x4){0.f, 0.f, 0.f, 0.f};
#pragma unroll
    for (int i = 0; i < 16; ++i) { const int k = wave * 16 + i; const f32x4 c0 = *(const LAS f32x4*)(cs + k * 8), c1 = *(const LAS f32x4*)(cs + k * 8 + 4);
        acc[0] += wv[i] * c0[0]; acc[1] += wv[i] * c0[1]; acc[2] += wv[i] * c0[2]; acc[3] += wv[i] * c0[3];
        acc[4] += wv[i] * c1[0]; acc[5] += wv[i] * c1[1]; acc[6] += wv[i] * c1[2]; acc[7] += wv[i] * c1[3]; }
#pragma unroll
    for (int b = 0; b < 8; ++b) *(LAS f32x4*)(red + (wave * 8 + b) * 256 + 4 * lane) = acc[b];
    __syncthreads();
    { const int b = tid >> 6, c4 = tid & 63; f32x4 sacc = (f32x4){0.f, 0.f, 0.f, 0.f};
#pragma unroll
      for (int w = 0; w < 8; ++w) sacc += *(const LAS f32x4*)(red + (w * 8 + b) * 256 + 4 * c4);
      *(f32x4*)(part + ((size_t)kc * NB + b) * NMOD + g * 256 + 4 * c4) = sacc; }
    __syncthreads();
}
__device__ __forceinline__ void transpose_item(const float* W, int K, int N, bf16_t* WT, int k0, int nsrc0, int rdst0, LAS float* scr, int lane) {
    { float tv[32];
#pragma unroll
      for (int i = 0; i < 32; ++i) { const int kk = 2 * i + (lane >> 5); tv[i] = W[(size_t)(k0 + kk) * N + nsrc0 + (lane & 31)]; }
#pragma unroll
      for (int i = 0; i < 32; ++i) { const int kk = 2 * i + (lane >> 5); scr[kk * 33 + (lane & 31)] = tv[i]; } }
    asm volatile("s_waitcnt lgkmcnt(0)" ::: "memory");
    const int c = lane & 7;
#pragma unroll
    for (int j = 0; j < 4; ++j) { const int n = (lane >> 3) + 8 * j; const LAS float* s = scr + (8 * c) * 33 + n;
        u32x4 o; o.x = cvt_pk_bf16(s[0 * 33], s[1 * 33]); o.y = cvt_pk_bf16(s[2 * 33], s[3 * 33]); o.z = cvt_pk_bf16(s[4 * 33], s[5 * 33]); o.w = cvt_pk_bf16(s[6 * 33], s[7 * 33]);
        *(u32x4*)(WT + (size_t)(rdst0 + n) * K + k0 + 8 * c) = o; }
    asm volatile("s_waitcnt lgkmcnt(0)" ::: "memory");
}
__device__ __forceinline__ void p0_convert_win_block(const Args& a, unsigned char* ws, LAS unsigned char* lds, int bitem, int lane, int wave) {
    LAS float* tile = (LAS float*)lds; bf16_t* WT = (bf16_t*)(ws + WS_WIN);
    const int kb = bitem / (DIN / 256), nbt = bitem % (DIN / 256), k0 = 64 * kb, h = lane >> 5, c4 = lane & 31;
    const int src0 = map_in(256 * nbt + 128 * h) + 4 * c4;
    f32x4 v[8];
#pragma unroll
    for (int i = 0; i < 8; ++i) v[i] = *(const f32x4*)(a.w_in + (size_t)(k0 + wave * 8 + i) * DIN + src0);
#pragma unroll
    for (int i = 0; i < 8; ++i) *(LAS f32x4*)(tile + (wave * 8 + i) * 260 + 128 * h + 4 * c4) = v[i];
    __syncthreads();
    const int c = lane & 7;
#pragma unroll
    for (int j = 0; j < 4; ++j) { const int n = wave * 32 + (lane >> 3) + 8 * j; const LAS float* sp = tile + (8 * c) * 260 + n;
        u32x4 o; o.x = cvt_pk_bf16(sp[0 * 260], sp[1 * 260]); o.y = cvt_pk_bf16(sp[2 * 260], sp[3 * 260]); o.z = cvt_pk_bf16(sp[4 * 260], sp[5 * 260]); o.w = cvt_pk_bf16(sp[6 * 260], sp[7 * 260]);
        *(u32x4*)(WT + (size_t)(256 * nbt + n) * D + k0 + 8 * c) = o; }
    __syncthreads();
}
constexpr int I_IN = (D / 64) * (DIN / 32), I_A = (DC / 64) * (D / 32), I_B = I_A, I_O = (D / 64) * (D / 32), I_GU = (D / 64) * (NGU / 32), I_DN = (DFF / 64) * (D / 32);
constexpr int NITEMS = I_IN + I_A + I_B + I_O + I_GU + I_DN;
__device__ __forceinline__ void p0_convert(const Args& a, unsigned char* ws, LAS unsigned char* lds, int gw, int NGW, int wave, int lane, int first, int last) {
    LAS float* scr = (LAS float*)(lds + 49152 + wave * 8448);
    for (int it = first + gw; it < last; it += NGW) {
        int r = it;
        if (r < I_IN) { const int nblk = DIN / 32, kb = r / nblk, nb = r % nblk; transpose_item(a.w_in, D, DIN, (bf16_t*)(ws + WS_WIN), 64 * kb, map_in(32 * nb), 32 * nb, scr, lane); continue; } r -= I_IN;
        if (r < I_A) { const int nblk = D / 32, kb = r / nblk, nb = r % nblk; transpose_item(a.conf_w_out, DC, D, (bf16_t*)(ws + WS_WA), 64 * kb, 32 * nb, 32 * nb, scr, lane); continue; } r -= I_A;
        if (r < I_B) { const int nblk = D / 32, kb = r / nblk, nb = r % nblk; transpose_item(a.sc_w_out, DC, D, (bf16_t*)(ws + WS_WB), 64 * kb, 32 * nb, 32 * nb, scr, lane); continue; } r -= I_B;
        if (r < I_O) { const int nblk = D / 32, kb = r / nblk, nb = r % nblk; transpose_item(a.w_o, D, D, (bf16_t*)(ws + WS_WO), 64 * kb, 32 * nb, 32 * nb, scr, lane); continue; } r -= I_O;
        if (r < I_GU) { const int nblk = NGU / 32, kb = r / nblk, nb = r % nblk; transpose_item(a.w_gu, D, NGU, (bf16_t*)(ws + WS_WGU), 64 * kb, map_gu(32 * nb), 32 * nb, scr, lane); continue; } r -= I_GU;
        { const int nblk = D / 32, kb = r / nblk, nb = r % nblk; transpose_item(a.w_down, DFF, D, (bf16_t*)(ws + WS_WDN), 64 * kb, 32 * nb, 32 * nb, scr, lane); }
    }
}
__device__ __forceinline__ float sumsq4(const f32x4 (&v)[4]) { float ss = 0.f;
#pragma unroll
    for (int j = 0; j < 4; ++j) ss += (v[j][0] * v[j][0] + v[j][1] * v[j][1]) + (v[j][2] * v[j][2] + v[j][3] * v[j][3]);
    return ss; }
__device__ __forceinline__ int own_row(int i, int wave, int G, int c) { return (G == 256) ? (c & 7) * SEQ + (c >> 3) * 64 + wave * 8 + i : (c * 8 + wave) + i * (G * 8); }
__device__ __forceinline__ int own_cnt(int G) { return (G == 256) ? 8 : (M + G * 8 - 1) / (G * 8); }
__device__ __forceinline__ const float* x1_row(unsigned char* arena, int m) { return (const float*)(arena + (size_t)(m >> 11) * ARENA + AO_X1) + (size_t)(m & (SEQ - 1)) * D; }
__device__ __forceinline__ void rownorm_mod(const float* xg, unsigned char* arena, const float* g, const float* mod, int sh_off, int sc_off, int wave, int G, int lane, int vid, const float* part = nullptr, const float* bias = nullptr) {
    const int cnt = own_cnt(G); int m = own_row(0, wave, G, vid); if (m >= M) return;
    f32x4 cur[4], nxt[4], mul[4], sh[4]; int bcur = -1;
    { const f32x4* xr = (const f32x4*)(xg ? xg + (size_t)m * D : x1_row(arena, m)) + lane;
#pragma unroll
      for (int j = 0; j < 4; ++j) cur[j] = xr[64 * j]; }
    for (int it = 0; it < cnt && m < M; ++it) { const int mn = (it + 1 < cnt) ? own_row(it + 1, wave, G, vid) : M;
        if (mn < M) { const f32x4* xr = (const f32x4*)(xg ? xg + (size_t)mn * D : x1_row(arena, mn)) + lane;
#pragma unroll
            for (int j = 0; j < 4; ++j) nxt[j] = xr[64 * j]; }
        const int b = m >> 11;
        if (b != bcur) { bcur = b;
#pragma unroll
            for (int j = 0; j < 4; ++j) { const int col = 4 * lane + 256 * j; const f32x4 gv = *(const f32x4*)(g + col); f32x4 sc;
                if (part) {
                    sc = *(const f32x4*)(bias + sc_off + col); sh[j] = *(const f32x4*)(bias + sh_off + col);
#pragma unroll
                    for (int kc = 0; kc < 8; ++kc) { const float* pp = part + ((size_t)kc * NB + b) * NMOD; sc += *(const f32x4*)(pp + sc_off + col); sh[j] += *(const f32x4*)(pp + sh_off + col); }
                } else { sc = *(const f32x4*)(mod + (size_t)b * MSTR + sc_off + col); sh[j] = *(const f32x4*)(mod + (size_t)b * MSTR + sh_off + col); }
                mul[j] = gv * (sc + 1.0f); } }
        const float rstd = rsqrtf(wave_sum(sumsq4(cur)) * (1.f / D) + RMS_EPS);
        u32x2* o8 = (u32x2*)((bf16_t*)(arena + (size_t)b * ARENA + AO_A1) + (size_t)(m & (SEQ - 1)) * D) + lane;
#pragma unroll
        for (int j = 0; j < 4; ++j) { const f32x4 o = cur[j] * rstd * mul[j] + sh[j]; u32x2 w; w.x = cvt_pk_bf16(o[0], o[1]); w.y = cvt_pk_bf16(o[2], o[3]); o8[64 * j] = w; }
#pragma unroll
        for (int j = 0; j < 4; ++j) cur[j] = nxt[j];
        m = mn; }
}
__device__ __forceinline__ void final_norm(unsigned char* arena, float* O, const float* g, int wave, int G, int lane, int vid) {
    f32x4 gv[4];
#pragma unroll
    for (int j = 0; j < 4; ++j) gv[j] = *(const f32x4*)(g + 4 * lane + 256 * j);
    const int cnt = own_cnt(G); f32x4 cur[4], nxt[4]; int m = own_row(0, wave, G, vid);
    if (m < M) { const f32x4* xr = (const f32x4*)x1_row(arena, m) + lane;
#pragma unroll
        for (int j = 0; j < 4; ++j) cur[j] = xr[64 * j]; }
    for (int it = 0; it < cnt && m < M; ++it) { const int mn = (it + 1 < cnt) ? own_row(it + 1, wave, G, vid) : M;
        if (mn < M) { const f32x4* xr = (const f32x4*)x1_row(arena, mn) + lane;
#pragma unroll
            for (int j = 0; j < 4; ++j) nxt[j] = xr[64 * j]; }
        const float rstd = rsqrtf(wave_sum(sumsq4(cur)) * (1.f / D) + RMS_EPS);
        f32x4* orow = (f32x4*)(O + (size_t)m * D) + lane;
#pragma unroll
        for (int j = 0; j < 4; ++j) orow[64 * j] = cur[j] * rstd * gv[j];
#pragma unroll
        for (int j = 0; j < 4; ++j) cur[j] = nxt[j];
        m = mn; }
}
__device__ __forceinline__ void p3_conv(const Args& a, unsigned char* arena, LAS unsigned char* lds, int tid, int lane, int wave, int vid) {
    LAS unsigned* buf = (LAS unsigned*)lds; LAS float* red = (LAS float*)(lds + 94 * 1024);
    const int cp = tid & 255, th = tid >> 8, w4 = wave & 3;
    f32x2 w[CONF_K];
#pragma unroll
    for (int k = 0; k < CONF_K; ++k) w[k] = *(const f32x2*)(a.conf_dw_w + k * DC + 2 * cp);
    const f32x2 cb = *(const f32x2*)(a.conf_dw_b + 2 * cp), lg = *(const f32x2*)(a.conf_ln_g + 2 * cp), lb = *(const f32x2*)(a.conf_ln_b + 2 * cp);
    const f32x2 w30 = *(const f32x2*)(a.sc_dw_w + 2 * cp), w31 = *(const f32x2*)(a.sc_dw_w + DC + 2 * cp), w32 = *(const f32x2*)(a.sc_dw_w + 2 * DC + 2 * cp);
    for (int tl = vid; tl < M / 64; tl += gridDim.x) {
        const int tile = (gridDim.x == 256) ? (tl & 7) * 32 + (tl >> 3) : tl;
        const int b = tile >> 5, t0 = (tile & 31) * 64;
        unsigned char* ab = arena + (size_t)b * ARENA;
        const bf16_t* U = (const bf16_t*)(ab + AO_U); const unsigned* GCV = (const unsigned*)(ab + AO_GCV); const unsigned* GBp = (const unsigned*)(ab + AO_GB);
        unsigned* UA = (unsigned*)(ab + AO_UA); unsigned* VB = (unsigned*)(ab + AO_VB);
        __syncthreads();
        { u32x4 sv[12];
#pragma unroll
          for (int i = 0; i < 12; ++i) { const int ch = tid + 512 * i, row = ch >> 6, c16 = ch & 63; sv[i] = (u32x4){0u, 0u, 0u, 0u};
              if (ch < 94 * 64 && (t0 != 0 || row >= 30)) sv[i] = *(const u32x4*)(U + (size_t)(t0 - 30 + row) * DC + c16 * 8); }
#pragma unroll
          for (int i = 0; i < 12; ++i) { const int ch = tid + 512 * i, row = ch >> 6, c16 = ch & 63; if (ch < 94 * 64) *(LAS u32x4*)(lds + row * 1024 + c16 * 16) = sv[i]; } }
        __syncthreads();
#pragma unroll 1
        for (int chunk = 0; chunk < 4; ++chunk) {
            const int tb = t0 + th * 32 + chunk * 8; unsigned gc[10], gbv[8];
            { const bool head = (tb == 0);
              gc[0] = head ? 0u : GCV[(size_t)(tb - 2) * (DC / 2) + cp]; gc[1] = head ? 0u : GCV[(size_t)(tb - 1) * (DC / 2) + cp];
#pragma unroll
              for (int tt = 0; tt < 8; ++tt) { gc[2 + tt] = GCV[(size_t)(tb + tt) * (DC / 2) + cp]; gbv[tt] = GBp[(size_t)(tb + tt) * (DC / 2) + cp]; } }
            float y0[8], y1[8];
#pragma unroll
            for (int tt = 0; tt < 8; ++tt) { const int lt = th * 32 + chunk * 8 + tt; float a0 = cb[0], a1 = cb[1];
#pragma unroll
                for (int k = 0; k < CONF_K; ++k) { const unsigned v = buf[(lt + k) * 256 + cp]; a0 += w[k][0] * bf_lo(v); a1 += w[k][1] * bf_hi(v); }
                y0[tt] = a0; y1[tt] = a1; }
#pragma unroll
            for (int tt = 0; tt < 8; ++tt) { const float sq = wave_sum(y0[tt] + y1[tt]), q = wave_sum(y0[tt] * y0[tt] + y1[tt] * y1[tt]);
                if (lane == 0) { red[((tt * 2 + th) * 4 + w4) * 2 + 0] = sq; red[((tt * 2 + th) * 4 + w4) * 2 + 1] = q; } }
            __syncthreads();
#pragma unroll
            for (int tt = 0; tt < 8; ++tt) { const int lt = th * 32 + chunk * 8 + tt; const LAS float* r = red + (tt * 2 + th) * 8;
                const float S = (r[0] + r[2]) + (r[4] + r[6]), Q = (r[1] + r[3]) + (r[5] + r[7]);
                const float mean = S * (1.f / DC), var = fmaxf(Q * (1.f / DC) - mean * mean, 0.f), rstd = rsqrtf(var + LN_EPS);
                const float z0 = (y0[tt] - mean) * rstd * lg[0] + lb[0], z1 = (y1[tt] - mean) * rstd * lg[1] + lb[1];
                UA[(size_t)(t0 + lt) * (DC / 2) + cp] = cvt_pk_bf16(z0 * sigm(z0), z1 * sigm(z1)); }
#pragma unroll
            for (int tt = 0; tt < 8; ++tt) { const unsigned p2 = gc[tt], p1 = gc[tt + 1], cur = gc[tt + 2], gb = gbv[tt];
                const float r0 = w30[0] * bf_lo(p2) + w31[0] * bf_lo(p1) + w32[0] * bf_lo(cur), r1 = w30[1] * bf_hi(p2) + w31[1] * bf_hi(p1) + w32[1] * bf_hi(cur);
                VB[(size_t)(tb + tt) * (DC / 2) + cp] = cvt_pk_bf16(bf_lo(gb) * r0, bf_hi(gb) * r1); }
            __syncthreads();
        }
    }
}

__global__ void __launch_bounds__(512, 2) mega(Args a) {
    extern __shared__ __attribute__((aligned(16))) unsigned char lds_raw[];
    LAS unsigned char* lds = (LAS unsigned char*)lds_raw;
    const int G = gridDim.x;
#define PHASE_IDS const int tid = opaque_tid(), lane = tid & 63, wave = __builtin_amdgcn_readfirstlane(tid >> 6); (void)tid; (void)lane; (void)wave
    unsigned char* ws = a.ws; unsigned char* arena = ws + WS_ARENA; float* mod = (float*)(arena + AO_MODX); float* modp = (float*)(ws + WS_MODP);
    volatile LAS unsigned* misc = (volatile LAS unsigned*)(lds + 131072);
    unsigned* ctl = (unsigned*)ws;
#define VID ((int)misc[2])
#define GRID_BARRIER(idx) do { asm volatile("s_waitcnt vmcnt(0) lgkmcnt(0)" ::: "memory"); __syncthreads(); \
        if (threadIdx.x == 0) { unsigned* bw = ctl + 1024 + 64 * (idx); __builtin_amdgcn_fence(__ATOMIC_RELEASE, "agent"); asm volatile("s_waitcnt vmcnt(0)" ::: "memory"); \
            __hip_atomic_fetch_add(bw, 1u, __ATOMIC_RELAXED, __HIP_MEMORY_SCOPE_AGENT); \
            while (__hip_atomic_load(bw, __ATOMIC_RELAXED, __HIP_MEMORY_SCOPE_AGENT) < gridDim.x) __builtin_amdgcn_s_sleep(1); \
            __builtin_amdgcn_fence(__ATOMIC_ACQUIRE, "agent"); asm volatile("s_waitcnt vmcnt(0)" ::: "memory"); } \
        __syncthreads(); asm volatile("" ::: "memory"); } while (0)
#define SEAM(k) do { if (misc[3] != 0u) { asm volatile("s_waitcnt vmcnt(0) lgkmcnt(0)" ::: "memory"); __syncthreads(); \
            if (threadIdx.x == 0) { unsigned* bw = ctl + 2048 + 64 * misc[0] + (k); __hip_atomic_fetch_add(bw, 1u, __ATOMIC_RELAXED, __HIP_MEMORY_SCOPE_AGENT); \
                while (__hip_atomic_load(bw, __ATOMIC_RELAXED, __HIP_MEMORY_SCOPE_AGENT) < 32u) __builtin_amdgcn_s_sleep(1); \
                __builtin_amdgcn_fence(__ATOMIC_ACQUIRE, "agent"); asm volatile("s_waitcnt vmcnt(0)" ::: "memory"); } \
            __syncthreads(); asm volatile("" ::: "memory"); } else GRID_BARRIER(k); } while (0)

    if (threadIdx.x == 0) { const unsigned xcc = (unsigned)__builtin_amdgcn_s_getreg((3 << 11) | 20) & 0xFu;
        misc[0] = xcc; misc[1] = __hip_atomic_fetch_add(ctl + 64 * xcc, 1u, __ATOMIC_RELAXED, __HIP_MEMORY_SCOPE_AGENT); misc[2] = blockIdx.x; misc[3] = 0u; }

    { PHASE_IDS; const int gw = ((G == 256) ? (int)((blockIdx.x + 64u) & 255u) : (int)blockIdx.x) * 8 + wave, NGW = G * 8;
        if (G == 256) { if (blockIdx.x < 192) p0_mod_ksplit(a, modp, lds, blockIdx.x, tid, lane, wave); }
        else if (G > 256) { if (blockIdx.x < 192) p0_mod(a, mod, lds, blockIdx.x, tid, lane, wave); }
        else { for (int it = blockIdx.x; it < 192; it += G) p0_mod(a, mod, lds, it, tid, lane, wave); }
        if (G == 256) {
            p0_convert_win_block(a, ws, lds, (int)blockIdx.x, lane, wave);
            if (blockIdx.x >= 224) p0_convert_win_block(a, ws, lds, 256 + (int)blockIdx.x - 224, lane, wave);
        } else p0_convert(a, ws, lds, gw, NGW, wave, lane, 0, NITEMS);
    }
    if (gridDim.x == 0xFFFFFFFFu) cg::this_grid().sync();
    GRID_BARRIER(0);
    if (threadIdx.x == 0) {
        bool even = (G == 256);
        for (int j = 0; j < 16; ++j) { const unsigned cnt = __hip_atomic_load(ctl + 64 * j, __ATOMIC_RELAXED, __HIP_MEMORY_SCOPE_AGENT); if (cnt != (j < 8 ? 32u : 0u)) even = false; }
        if (even) { misc[2] = misc[1] * 8u + misc[0]; misc[3] = 1u; } }
    __syncthreads();

    if (G == 256) { PHASE_IDS; const int vid = VID, b = vid & 7, col = (vid >> 3) * 192 + tid;
        if (tid < 192) { float sv = a.b_ada[col];
#pragma unroll
            for (int kc = 0; kc < 8; ++kc) sv += modp[((size_t)kc * NB + b) * NMOD + col];
            mod[(size_t)b * MSTR + col] = sv; }
        rownorm_mod(a.x, arena, a.norm1_g, mod, MO_SH1, MO_SC1, wave, G, lane, vid, modp, a.b_ada);
    } else { PHASE_IDS; rownorm_mod(a.x, arena, a.norm1_g, mod, MO_SH1, MO_SC1, wave, G, lane, VID); }
    SEAM(1);
    { pg8::Gemm g{arena, (unsigned)AO_A1, 0u, (const bf16_t*)(ws + WS_WIN), nullptr, D}; pg8::Order S; S.init(M, DIN, G, VID, 0);
      EpiIn E{arena, a.b_glu, a.b_gate}; pg8::gemm_phase(lds, g, S, E); }
    if (G == 256 && VID >= 128) { PHASE_IDS;
        p0_convert(a, ws, lds, (VID - 128) * 8 + wave, 1024, wave, lane, I_IN, NITEMS);
        asm volatile("s_waitcnt vmcnt(0) lgkmcnt(0)" ::: "memory"); __syncthreads();
        if (threadIdx.x == 0) { __builtin_amdgcn_fence(__ATOMIC_RELEASE, "agent"); asm volatile("s_waitcnt vmcnt(0)" ::: "memory");
            __hip_atomic_fetch_add(ctl + 1792, 1u, __ATOMIC_RELAXED, __HIP_MEMORY_SCOPE_AGENT); } }
    SEAM(2);
    { PHASE_IDS; p3_conv(a, arena, lds, tid, lane, wave, VID); }
    if (G == 256 && threadIdx.x == 0) { unsigned spins = 0;
        while (__hip_atomic_load(ctl + 1792, __ATOMIC_RELAXED, __HIP_MEMORY_SCOPE_AGENT) < 128u) { __builtin_amdgcn_s_sleep(2); if (++spins > (1u << 20)) break; } }
    SEAM(3);
    { pg8::Gemm g{arena, (unsigned)AO_UA, (unsigned)AO_VB, (const bf16_t*)(ws + WS_WA), (const bf16_t*)(ws + WS_WB), DC}; pg8::Order S; S.init(M, D, G, VID, 1);
      EpiDual E{arena, a.conf_b_out}; pg8::gemm_phase(lds, g, S, E); }
    SEAM(4);
    if (G == 256) {
        pg8::Gemm g{arena, (unsigned)AO_MIX, 0u, (const bf16_t*)(ws + WS_WO), nullptr, D}; pg8::Order S; S.init(M, D, G, VID, 0);
        EpiResNorm E{arena, a.x, mod, a.norm2_g, (float*)(ws + WS_XCH + 512 * 1024), ctl + 6144}; pg8::gemm_phase(lds, g, S, E);
        SEAM(5);
    } else {
        { pg8::Gemm g{arena, (unsigned)AO_MIX, 0u, (const bf16_t*)(ws + WS_WO), nullptr, D}; pg8::Order S; S.init(M, D, G, VID, 0);
          EpiRes<true> E{arena, a.x, mod + MO_GT1}; pg8::gemm_phase(lds, g, S, E); }
        SEAM(5);
        { PHASE_IDS; rownorm_mod(nullptr, arena, a.norm2_g, mod, MO_SH2, MO_SC2, wave, G, lane, VID); }
        SEAM(6);
    }
    { pg8::Gemm g{arena, (unsigned)AO_A1, 0u, (const bf16_t*)(ws + WS_WGU), nullptr, D}; pg8::Order S; S.init(M, NGU, G, VID, 0);
      EpiGU E{arena}; pg8::gemm_phase(lds, g, S, E); }
    SEAM(7);
    if (G == 256) {
        pg8::Gemm g{arena, (unsigned)AO_ACT, 0u, (const bf16_t*)(ws + WS_WDN), nullptr, DFF}; pg8::Order S; S.init(M, D, G, VID, 0);
        EpiFinal E{arena, mod + MO_GT2, a.final_g, a.out, (float*)(ws + WS_XCH), ctl + 4096}; pg8::gemm_phase(lds, g, S, E);
    } else {
        { pg8::Gemm g{arena, (unsigned)AO_ACT, 0u, (const bf16_t*)(ws + WS_WDN), nullptr, DFF}; pg8::Order S; S.init(M, D, G, VID, 0);
          EpiRes<false> E{arena, nullptr, mod + MO_GT2}; pg8::gemm_phase(lds, g, S, E); }
        SEAM(8);
        { PHASE_IDS; final_norm(arena, a.out, a.final_g, wave, G, lane, VID); }
    }
#undef SEAM
#undef GRID_BARRIER
#undef VID
#undef PHASE_IDS
}

extern "C" void kernel_launch(void* const* d_in, const int* in_sizes, int n_in, void* d_out, int out_size, void* d_ws, size_t ws_size, hipStream_t stream) {
    static int grid = 0;
    if (grid == 0) {
        if (n_in != 21 || out_size != M * D || ws_size < WS_END) { fprintf(stderr, "kernel_launch: unexpected shapes (n_in %d out %d ws %zu)\n", n_in, out_size, ws_size); grid = -1; return; }
        int dev = 0, cus = 0, per_cu = 0;
        (void)hipGetDevice(&dev); (void)hipDeviceGetAttribute(&cus, hipDeviceAttributeMultiprocessorCount, dev);
        if (hipFuncSetAttribute((const void*)mega, hipFuncAttributeMaxDynamicSharedMemorySize, LDS_BYTES) != hipSuccess) { fprintf(stderr, "kernel_launch: hipFuncSetAttribute failed\n"); grid = -1; return; }
        if (hipOccupancyMaxActiveBlocksPerMultiprocessor(&per_cu, (const void*)mega, 512, LDS_BYTES) != hipSuccess || per_cu < 1) { fprintf(stderr, "kernel_launch: occupancy query gave %d\n", per_cu); per_cu = 1; }
        (void)hipGetLastError();
        grid = cus * per_cu;
    }
    if (grid < 0) return;
    Args a{};
    const float** ap = (const float**)&a;
    for (int i = 0; i < 21; ++i) ap[i] = (const float*)d_in[i];
    a.out = (float*)d_out; a.ws = (unsigned char*)d_ws; a.ph_lo = 0; a.ph_hi = 10;
    (void)hipMemsetAsync(d_ws, 0, 32768, stream);
    void* args[] = {&a};
    hipError_t e = hipLaunchCooperativeKernel((const void*)mega, dim3(grid), dim3(512), args, LDS_BYTES, stream);
    if (e != hipSuccess) fprintf(stderr, "cooperative launch failed: %s (grid %d)\n", hipGetErrorString(e), grid);
}
```

```cpp
#include <hip/hip_runtime.h>
#include <hip/hip_cooperative_groups.h>
#include <cstdio>
#include <cstdint>
namespace cg = cooperative_groups;


#define LAS __attribute__((address_space(3)))
typedef unsigned short bf16_t;
typedef short bf16x8 __attribute__((ext_vector_type(8)));
typedef float f32x4 __attribute__((ext_vector_type(4)));
typedef float f32x2 __attribute__((ext_vector_type(2)));
typedef unsigned u32x4 __attribute__((ext_vector_type(4)));
typedef unsigned u32x2 __attribute__((ext_vector_type(2)));

constexpr int NB = 8, SEQ = 2048, D = 1024, M = NB * SEQ, DC = 512, DIN = 4608, DFF = 2816, NGU = 2 * DFF, NMOD = 6 * D;
constexpr int CONF_K = 31;
constexpr float RMS_EPS = 1e-6f, LN_EPS = 1e-5f;
constexpr int MO_SH1 = 0, MO_SC1 = D, MO_GT1 = 2 * D, MO_SH2 = 3 * D, MO_SC2 = 4 * D, MO_GT2 = 5 * D;

constexpr size_t MiB = 1u << 20;
constexpr size_t WS_MOD = 1 * MiB;
constexpr size_t WS_XCH = 2 * MiB;
constexpr size_t WS_WIN = 8 * MiB;
constexpr size_t WS_WA = 17 * MiB;
constexpr size_t WS_WB = 18 * MiB;
constexpr size_t WS_WO = 19 * MiB;
constexpr size_t WS_WGU = 21 * MiB;
constexpr size_t WS_WDN = 32 * MiB;
constexpr size_t WS_ARENA = 40 * MiB, ARENA = 24 * MiB;
constexpr size_t AO_A1 = 0;
constexpr size_t AO_UA = 0, AO_VB = 2 * MiB;
constexpr size_t AO_U = 4 * MiB, AO_GCV = 6 * MiB, AO_GB = 8 * MiB;
constexpr size_t AO_T = 4 * MiB;
constexpr size_t AO_MIX = 10 * MiB;
constexpr size_t AO_ACT = 4 * MiB;
constexpr size_t AO_GATES = 15 * MiB;
constexpr size_t AO_X1 = 15 * MiB;
constexpr size_t AO_MODX = 23 * MiB;
constexpr size_t WS_MODP = 3 * MiB;
constexpr int MSTR = (int)(ARENA / 4);
constexpr size_t WS_END = WS_ARENA + 8 * ARENA;
constexpr int LDS_BYTES = 131072 + 2048;

struct Args {
    const float *x, *c, *w_ada, *b_ada, *norm1_g, *w_in, *b_glu, *conf_dw_w, *conf_dw_b, *conf_ln_g, *conf_ln_b, *conf_w_out, *conf_b_out,
        *sc_dw_w, *sc_w_out, *b_gate, *w_o, *norm2_g, *w_gu, *w_down, *final_g;
    float* out; unsigned char* ws; int ph_lo, ph_hi;
};

__device__ __forceinline__ float bf_lo(unsigned v) { return __uint_as_float(v << 16); }
__device__ __forceinline__ float bf_hi(unsigned v) { return __uint_as_float(v & 0xffff0000u); }
__device__ __forceinline__ float bf2f(bf16_t v) { return __uint_as_float(((unsigned)v) << 16); }
typedef __bf16 bf16x2_t __attribute__((ext_vector_type(2)));
__device__ __forceinline__ unsigned cvt_pk_bf16(float lo, float hi) { const f32x2 v = {lo, hi}; const bf16x2_t b = __builtin_convertvector(v, bf16x2_t); return __builtin_bit_cast(unsigned, b); }
__device__ __forceinline__ bf16_t f2bf(float f) { return (bf16_t)(cvt_pk_bf16(f, 0.f) & 0xffffu); }
__device__ __forceinline__ u32x4 pack8(const f32x4 a, const f32x4 b) { u32x4 w; w.x = cvt_pk_bf16(a[0], a[1]); w.y = cvt_pk_bf16(a[2], a[3]); w.z = cvt_pk_bf16(b[0], b[1]); w.w = cvt_pk_bf16(b[2], b[3]); return w; }
__device__ __forceinline__ void unpack8(const u32x4 w, f32x4& a, f32x4& b) { a[0] = bf_lo(w.x); a[1] = bf_hi(w.x); a[2] = bf_lo(w.y); a[3] = bf_hi(w.y); b[0] = bf_lo(w.z); b[1] = bf_hi(w.z); b[2] = bf_lo(w.w); b[3] = bf_hi(w.w); }
__device__ __forceinline__ float sigm(float x) { return __builtin_amdgcn_rcpf(1.0f + __builtin_amdgcn_exp2f(-1.4426950408889634f * x)); }
__device__ __forceinline__ int opaque_tid() { int t = threadIdx.x; asm volatile("" : "+v"(t)); return t; }
__device__ __forceinline__ float wave_sum(float v) {
#pragma unroll
    for (int o = 1; o < 64; o <<= 1) v += __shfl_xor(v, o);
    return v;
}
__device__ __forceinline__ int map_in(int r) {
    const int t = r >> 8, j = r & 255, h = j >> 7, jj = j & 127;
    if (t < 4) return h * 512 + 128 * t + jj;
    if (t < 6) return 1024 + 256 * (t - 4) + j;
    if (t < 10) return (h ? 2048 : 1536) + 128 * (t - 6) + jj;
    return 2560 + 256 * (t - 10) + j;
}
__device__ __forceinline__ int map_gu(int r) { const int t = r >> 8, j = r & 255, h = j >> 7, jj = j & 127; return h * DFF + 128 * t + jj; }

namespace pg8 {
constexpr int BM = 256, BK = 64, HALF = 128, HTB = HALF * BK * 2, STAGE_BYTES = 8 * HTB, NXCD = 8, WGM = 8;
__device__ __forceinline__ int lds_byte(int r, int c) { const int st = (r >> 4) * 2 + (c >> 5), rr = r & 15, cc = c & 31, ob = rr * 64 + cc * 2; return st * 1024 + (ob ^ (((ob >> 9) & 1) << 5)); }
__device__ __forceinline__ void stage_rc(int b, int& R, int& C) { const int st = b / 1024, sb = b % 1024, swz = sb ^ (((sb >> 9) & 1) << 5); R = (st >> 1) * 16 + swz / 64; C = (st & 1) * 32 + (swz % 64) / 2; }
__device__ __forceinline__ int perm32(int rho) { const int n = rho >> 4, i = rho & 15; return 8 * (i >> 2) + 4 * n + (i & 3); }

struct Unit { int pm, pn, sel; };
struct Gemm { const unsigned char* arena; unsigned offA0, offA1; const bf16_t *B0, *B1; int K; };

struct Order {
    int nM, nN, nwg, G, c, dual;
    __device__ void init(int M_, int N_, int G_, int c_, int dual_) { nM = M_ / BM; nN = N_ / BM; nwg = nM * nN; G = G_; c = c_; dual = dual_; }
    __device__ bool next(int i, Unit& u) const {
        const int ii = dual ? (i >> 1) : i;
        const long L = (long)ii * G + c; if (L >= nwg) return false;
        int wgid = (int)L; { const int q = nwg / NXCD, r = nwg % NXCD, xcd = wgid % NXCD, off = wgid / NXCD; wgid = (xcd < r ? xcd * (q + 1) : r * (q + 1) + (xcd - r) * q) + off; }
        const int nig = WGM * nN, gid = wgid / nig, fm = gid * WGM, gsz = (nM - fm) < WGM ? (nM - fm) : WGM;
        u.pm = fm + ((wgid % nig) % gsz); u.pn = (wgid % nig) / gsz; u.sel = dual ? (i & 1) : 0; return true;
    }
};

template <bool ALIGN_EPI = true, class Epi>
__device__ __forceinline__ void gemm_phase(LAS unsigned char* lds, const Gemm g, const Order& S, const Epi& E) {
    const int tid = opaque_tid(), wid = __builtin_amdgcn_readfirstlane(tid >> 6), lane = tid & 63, wr = wid >> 2, wc = wid & 3, fr = lane & 15, fq = lane >> 4;
    const int K = g.K, nt = K / BK;
    unsigned voffA[2], voffB[2];
#pragma unroll
    for (int i = 0; i < 2; ++i) { int R, C; stage_rc(tid * 16 + i * 8192, R, C); const int Rb = (R & ~31) + perm32(R & 31);
        voffA[i] = (unsigned)(R * K + C) * 2u; voffB[i] = (unsigned)(Rb * K + C) * 2u; }
    const size_t kstep = (size_t)(BK * 2);
    const size_t hstep = (size_t)HALF * K * 2;
    const size_t tstep = 2 * hstep;
    const unsigned ldsw = (unsigned)wid * 1024u;
    const int aoff = lds_byte(wr * 64 + fr, fq * 8), boff = lds_byte(wc * 32 + fr, fq * 8);
#define PG8_SA(b, h) (((b) * 2 + (h)) * HTB)
#define PG8_SB(b, h) ((4 + (b) * 2 + (h)) * HTB)
#define PG8_STAGE(bufoff, gbase, voff) do { _Pragma("unroll") for (int _i = 0; _i < 2; ++_i) \
        __builtin_amdgcn_global_load_lds((const unsigned*)((const char*)(gbase) + (voff)[_i]), (LAS unsigned*)(lds + (bufoff) + ldsw + _i * 8192), 16, 0, 0); } while (0)
#define PG8_LDA(dst, b, h) do { _Pragma("unroll") for (int m = 0; m < 4; ++m) _Pragma("unroll") for (int k = 0; k < 2; ++k) dst[m][k] = *(const LAS bf16x8*)(lds + PG8_SA(b, h) + aoff + m * 2048 + k * 1024); } while (0)
#define PG8_LDB(dst, b, h) do { _Pragma("unroll") for (int n = 0; n < 2; ++n) _Pragma("unroll") for (int k = 0; k < 2; ++k) dst[n][k] = *(const LAS bf16x8*)(lds + PG8_SB(b, h) + boff + n * 2048 + k * 1024); } while (0)
#define PG8_MMA(ai, bj, At, Bt) do { __builtin_amdgcn_s_setprio(1); _Pragma("unroll") for (int m = 0; m < 4; ++m) _Pragma("unroll") for (int n = 0; n < 2; ++n) _Pragma("unroll") for (int k = 0; k < 2; ++k) \
        acc[ai][bj][m][n] = __builtin_amdgcn_mfma_f32_16x16x32_bf16(Bt[n][k], At[m][k], acc[ai][bj][m][n], 0, 0, 0); __builtin_amdgcn_s_setprio(0); } while (0)
#define PG8_WAIT_V(n) asm volatile("s_waitcnt vmcnt(" #n ")" ::: "memory")
#define PG8_WAIT_L(n) asm volatile("s_waitcnt lgkmcnt(" #n ")" ::: "memory")
#define PG8_BAR __builtin_amdgcn_s_barrier()
#define PG8_SCHED __builtin_amdgcn_sched_barrier(0)
    Unit cur, nxt; int ui = 0;
    if (!S.next(0, cur)) return;
    f32x4 acc[2][2][4][2];
#pragma unroll
    for (int a = 0; a < 2; ++a)
#pragma unroll
        for (int b = 0; b < 2; ++b)
#pragma unroll
            for (int m = 0; m < 4; ++m)
#pragma unroll
                for (int n = 0; n < 2; ++n) acc[a][b][m][n] = (f32x4){0.f, 0.f, 0.f, 0.f};
    bf16x8 At[4][2], B0[2][2], B1[2][2];
    const char* cA = (const char*)g.arena + (size_t)(cur.pm >> 3) * ARENA + (cur.sel ? g.offA1 : g.offA0) + (size_t)(cur.pm & 7) * tstep; const char* cB = (const char*)(cur.sel ? g.B1 : g.B0) + (size_t)cur.pn * tstep;
    PG8_STAGE(PG8_SB(0, 0), cB, voffB); PG8_STAGE(PG8_SB(0, 1), cB + hstep, voffB); PG8_STAGE(PG8_SA(0, 0), cA, voffA); PG8_STAGE(PG8_SA(0, 1), cA + hstep, voffA);
    if (wr == 1) PG8_BAR;
    PG8_WAIT_V(2); PG8_BAR;
    PG8_STAGE(PG8_SB(1, 0), cB + kstep, voffB); PG8_STAGE(PG8_SA(1, 0), cA + kstep, voffA); PG8_STAGE(PG8_SB(1, 1), cB + hstep + kstep, voffB);
    PG8_WAIT_V(6); PG8_BAR;
    for (;;) {
        const bool has_next = S.next(ui + 1, nxt);
        const char* nA = has_next ? (const char*)g.arena + (size_t)(nxt.pm >> 3) * ARENA + (nxt.sel ? g.offA1 : g.offA0) + (size_t)(nxt.pm & 7) * tstep : cA; const char* nB = has_next ? (const char*)(nxt.sel ? g.B1 : g.B0) + (size_t)nxt.pn * tstep : cB;
        for (int t = 0; t < nt; t += 2) {
            const bool last = (t == nt - 2);
            const char* a1 = cA + (size_t)(t + 1) * kstep;
            const char* a2 = last ? nA : cA + (size_t)(t + 2) * kstep; const char* b2 = last ? nB : cB + (size_t)(t + 2) * kstep;
            const char* a3 = a2 + kstep; const char* b3 = b2 + kstep;
            PG8_LDB(B0, 0, 0); PG8_LDB(B1, 0, 1); PG8_SCHED; PG8_LDA(At, 0, 0); PG8_STAGE(PG8_SA(1, 1), a1 + hstep, voffA);
            PG8_WAIT_V(8); PG8_WAIT_L(0); PG8_BAR; PG8_MMA(0, 0, At, B0); PG8_MMA(0, 1, At, B1); PG8_BAR; PG8_SCHED;
            PG8_LDA(At, 0, 1); PG8_STAGE(PG8_SB(0, 0), b2, voffB); PG8_STAGE(PG8_SB(0, 1), b2 + hstep, voffB); PG8_STAGE(PG8_SA(0, 0), a2, voffA);
            PG8_WAIT_V(8); PG8_WAIT_L(0); PG8_BAR; PG8_MMA(1, 0, At, B0); PG8_MMA(1, 1, At, B1); PG8_BAR; PG8_SCHED;
            PG8_LDB(B0, 1, 0); PG8_LDB(B1, 1, 1); PG8_SCHED; PG8_LDA(At, 1, 0); PG8_STAGE(PG8_SA(0, 1), a2 + hstep, voffA);
            PG8_WAIT_V(8); PG8_WAIT_L(0); PG8_BAR; PG8_MMA(0, 0, At, B0); PG8_MMA(0, 1, At, B1); PG8_BAR; PG8_SCHED;
            PG8_LDA(At, 1, 1); PG8_STAGE(PG8_SB(1, 0), b3, voffB); PG8_STAGE(PG8_SB(1, 1), b3 + hstep, voffB); PG8_STAGE(PG8_SA(1, 0), a3, voffA);
            PG8_WAIT_V(8); PG8_WAIT_L(0); PG8_BAR; PG8_MMA(1, 0, At, B0); PG8_MMA(1, 1, At, B1); PG8_BAR; PG8_SCHED;
        }
        if constexpr (ALIGN_EPI) { if (wr == 0) PG8_BAR; }
        if constexpr (Epi::TRANSFORM) { if (cur.sel == 0) E.transform(acc, cur, wr, wc, fr, fq); else E(acc, cur, wr, wc, fr, fq); }
        else if constexpr (!Epi::AFTER_DRAIN) E(acc, cur, wr, wc, fr, fq);
        if (!has_next) break;
        if (!(Epi::TRANSFORM && cur.sel == 0))
#pragma unroll
        for (int a = 0; a < 2; ++a)
#pragma unroll
            for (int b = 0; b < 2; ++b)
#pragma unroll
                for (int m = 0; m < 4; ++m)
#pragma unroll
                    for (int n = 0; n < 2; ++n) acc[a][b][m][n] = (f32x4){0.f, 0.f, 0.f, 0.f};
        cur = nxt; cA = nA; cB = nB; ++ui;
        if constexpr (ALIGN_EPI) { if (wr == 1) PG8_BAR; }
    }
    PG8_WAIT_V(0);
    if constexpr (!ALIGN_EPI) { if (wr == 0) PG8_BAR; }
    PG8_BAR;
    if constexpr (Epi::AFTER_DRAIN) E.fused(acc, cur, wr, wc, fr, fq, lds, wid, lane);
#undef PG8_SA
#undef PG8_SB
#undef PG8_STAGE
#undef PG8_LDA
#undef PG8_LDB
#undef PG8_MMA
#undef PG8_WAIT_V
#undef PG8_WAIT_L
#undef PG8_BAR
#undef PG8_SCHED
}
}

typedef const f32x4 (&AccRef)[2][2][4][2];
#define EPI_ROWS const int rl0 = (u.pm & 7) * 256 + wr * 64 + fr; unsigned char* const ab = arena + (size_t)(u.pm >> 3) * ARENA
struct EpiIn {
    static constexpr bool AFTER_DRAIN = false, TRANSFORM = false;
    unsigned char* arena; const float *b_glu, *b_gate;
    __device__ __forceinline__ void operator()(AccRef acc, const pg8::Unit& u, int wr, int wc, int fr, int fq) const {
        EPI_ROWS; const int t = u.pn, cw = wc * 32 + fq * 8;
        if (t < 4) {
            bf16_t* U = (bf16_t*)(ab + AO_U); const int cA = 128 * t + cw; f32x4 ba[2], bb[2];
#pragma unroll
            for (int n = 0; n < 2; ++n) { ba[n] = *(const f32x4*)(b_glu + cA + 4 * n); bb[n] = *(const f32x4*)(b_glu + 512 + cA + 4 * n); }
#pragma unroll
            for (int ai = 0; ai < 2; ++ai)
#pragma unroll
                for (int m = 0; m < 4; ++m) { f32x4 r[2];
#pragma unroll
                    for (int n = 0; n < 2; ++n) { const f32x4 a = acc[ai][0][m][n] + ba[n], b = acc[ai][1][m][n] + bb[n];
#pragma unroll
                        for (int j = 0; j < 4; ++j) r[n][j] = a[j] * sigm(b[j]); }
                    *(u32x4*)(U + (size_t)(rl0 + ai * 128 + m * 16) * DC + cA) = pack8(r[0], r[1]); }
        } else if (t < 6) {
            bf16_t* GB = (bf16_t*)(ab + AO_GB); const int c0 = 256 * (t - 4) + cw;
#pragma unroll
            for (int ai = 0; ai < 2; ++ai)
#pragma unroll
                for (int m = 0; m < 4; ++m)
#pragma unroll
                    for (int bj = 0; bj < 2; ++bj) *(u32x4*)(GB + (size_t)(rl0 + ai * 128 + m * 16) * DC + c0 + 128 * bj) = pack8(acc[ai][bj][m][0], acc[ai][bj][m][1]);
        } else if (t < 10) {
            bf16_t* GCV = (bf16_t*)(ab + AO_GCV); const int cA = 128 * (t - 6) + cw;
#pragma unroll
            for (int ai = 0; ai < 2; ++ai)
#pragma unroll
                for (int m = 0; m < 4; ++m)
                    *(u32x4*)(GCV + (size_t)(rl0 + ai * 128 + m * 16) * DC + cA) = pack8(acc[ai][0][m][0] * acc[ai][1][m][0], acc[ai][0][m][1] * acc[ai][1][m][1]);
        } else {
            unsigned char* GATES = ab + AO_GATES; const int c0 = 256 * (t - 10) + cw, cg16 = 256 * (t - 10) + wc * 64 + fq * 16; f32x4 bv[2][2]; const float qmin = (t >= 14) ? 1.0f : 0.0f;
#pragma unroll
            for (int bj = 0; bj < 2; ++bj)
#pragma unroll
                for (int n = 0; n < 2; ++n) bv[bj][n] = *(const f32x4*)(b_gate + c0 + 128 * bj + 4 * n);
#pragma unroll
            for (int ai = 0; ai < 2; ++ai)
#pragma unroll
                for (int m = 0; m < 4; ++m)
                    { u32x4 w4;
#pragma unroll
                      for (int bj = 0; bj < 2; ++bj)
#pragma unroll
                        for (int n = 0; n < 2; ++n) { const f32x4 a = acc[ai][bj][m][n] + bv[bj][n]; unsigned q = 0u;
#pragma unroll
                            for (int j = 0; j < 4; ++j) q = __builtin_amdgcn_cvt_pk_u8_f32(fmaxf(255.0f * sigm(a[j]), qmin), j, q);
                            w4[bj * 2 + n] = q; }
                      *(u32x4*)(GATES + (size_t)(rl0 + ai * 128 + m * 16) * 2048 + cg16) = w4; }
        }
    }
};
struct EpiDual {
    static constexpr bool AFTER_DRAIN = false, TRANSFORM = true;
    unsigned char* arena; const float* b_out;
    __device__ __forceinline__ void transform(f32x4 (&acc)[2][2][4][2], const pg8::Unit& u, int wr, int wc, int fr, int fq) const {
        EPI_ROWS; const int c0 = 256 * u.pn + wc * 32 + fq * 8, cg16 = 256 * u.pn + wc * 64 + fq * 16; const unsigned char* GA = ab + AO_GATES; f32x4 bv[2][2];
#pragma unroll
        for (int bj = 0; bj < 2; ++bj)
#pragma unroll
            for (int n = 0; n < 2; ++n) bv[bj][n] = *(const f32x4*)(b_out + c0 + 128 * bj + 4 * n);
        u32x4 ac = *(const u32x4*)(GA + (size_t)rl0 * 2048 + cg16), bc = *(const u32x4*)(GA + (size_t)rl0 * 2048 + 1024 + cg16), an, bn;
#pragma unroll
        for (int g = 0; g < 8; ++g) { const int ai = g >> 2, m = g & 3;
            if (g < 7) { const size_t rown = (size_t)(rl0 + ((g + 1) >> 2) * 128 + ((g + 1) & 3) * 16);
                an = *(const u32x4*)(GA + rown * 2048 + cg16); bn = *(const u32x4*)(GA + rown * 2048 + 1024 + cg16); }
#pragma unroll
            for (int bj = 0; bj < 2; ++bj)
#pragma unroll
                for (int n = 0; n < 2; ++n)
#pragma unroll
                    for (int j = 0; j < 4; ++j) {
                        const float r = (float)((ac[bj * 2 + n] >> (8 * j)) & 0xffu) * __builtin_amdgcn_rcpf((float)((bc[bj * 2 + n] >> (8 * j)) & 0xffu));
                        acc[ai][bj][m][n][j] = (acc[ai][bj][m][n][j] + bv[bj][n][j]) * r; }
            ac = an; bc = bn;
            asm volatile("" ::: "memory"); }
    }
    __device__ __forceinline__ void operator()(AccRef acc, const pg8::Unit& u, int wr, int wc, int fr, int fq) const {
        EPI_ROWS; const int c0 = 256 * u.pn + wc * 32 + fq * 8, cg16 = 256 * u.pn + wc * 64 + fq * 16; bf16_t* MIX = (bf16_t*)(ab + AO_MIX); const unsigned char* GB = ab + AO_GATES + 1024;
        u32x4 bc = *(const u32x4*)(GB + (size_t)rl0 * 2048 + cg16), bn;
#pragma unroll
        for (int g = 0; g < 8; ++g) { const int ai = g >> 2, m = g & 3;
            if (g < 7) { const size_t rown = (size_t)(rl0 + ((g + 1) >> 2) * 128 + ((g + 1) & 3) * 16); bn = *(const u32x4*)(GB + rown * 2048 + cg16); }
            const size_t row = (size_t)(rl0 + ai * 128 + m * 16);
#pragma unroll
            for (int bj = 0; bj < 2; ++bj) { f32x4 g0, g1;
#pragma unroll
                for (int j = 0; j < 4; ++j) { g0[j] = (float)((bc[bj * 2] >> (8 * j)) & 0xffu) * (1.0f / 255.0f); g1[j] = (float)((bc[bj * 2 + 1] >> (8 * j)) & 0xffu) * (1.0f / 255.0f); }
                *(u32x4*)(MIX + row * D + c0 + 128 * bj) = pack8(acc[ai][bj][m][0] * g0, acc[ai][bj][m][1] * g1); }
            bc = bn;
            asm volatile("" ::: "memory"); }
    }
};
template <bool FROM_X> struct EpiRes {
    static constexpr bool AFTER_DRAIN = false, TRANSFORM = false;
    unsigned char* arena; const float* x; const float* gt;
    __device__ __forceinline__ void operator()(AccRef acc, const pg8::Unit& u, int wr, int wc, int fr, int fq) const {
        EPI_ROWS; const int c0 = 256 * u.pn + wc * 32 + fq * 8, b = u.pm >> 3; f32x4 gv[2][2];
        float* xout = (float*)(ab + AO_X1); const float* xin = FROM_X ? x + (size_t)b * SEQ * D : (const float*)xout;
#pragma unroll
        for (int bj = 0; bj < 2; ++bj)
#pragma unroll
            for (int n = 0; n < 2; ++n) gv[bj][n] = *(const f32x4*)(gt + (size_t)b * MSTR + c0 + 128 * bj + 4 * n);
        f32x4 cur[2][2], nxt[2][2];
        { const size_t off = (size_t)rl0 * D + c0;
#pragma unroll
          for (int bj = 0; bj < 2; ++bj)
#pragma unroll
              for (int n = 0; n < 2; ++n) cur[bj][n] = *(const f32x4*)(xin + off + 128 * bj + 4 * n); }
#pragma unroll
        for (int g = 0; g < 8; ++g) { const int ai = g >> 2, m = g & 3;
            if (g < 7) { const size_t offn = (size_t)(rl0 + ((g + 1) >> 2) * 128 + ((g + 1) & 3) * 16) * D + c0;
#pragma unroll
                for (int bj = 0; bj < 2; ++bj)
#pragma unroll
                    for (int n = 0; n < 2; ++n) nxt[bj][n] = *(const f32x4*)(xin + offn + 128 * bj + 4 * n); }
            const size_t off = (size_t)(rl0 + ai * 128 + m * 16) * D + c0;
#pragma unroll
            for (int bj = 0; bj < 2; ++bj)
#pragma unroll
                for (int n = 0; n < 2; ++n) *(f32x4*)(xout + off + 128 * bj + 4 * n) = cur[bj][n] + gv[bj][n] * acc[ai][bj][m][n];
#pragma unroll
            for (int bj = 0; bj < 2; ++bj)
#pragma unroll
                for (int n = 0; n < 2; ++n) cur[bj][n] = nxt[bj][n];
            asm volatile("" ::: "memory"); }
    }
};
struct EpiFinal {
    static constexpr bool AFTER_DRAIN = true, TRANSFORM = false;
    unsigned char* arena; const float* gt; const float* fg; float* out; float* xch; unsigned* cnt;
    __device__ __forceinline__ void fused(f32x4 (&acc)[2][2][4][2], const pg8::Unit& u, int wr, int wc, int fr, int fq, LAS unsigned char* lds, int wid, int lane) const {
        EPI_ROWS; const int c0 = 256 * u.pn + wc * 32 + fq * 8, b = u.pm >> 3; f32x4 gv[2][2];
        const bf16_t* xin = (const bf16_t*)(ab + AO_X1);
#pragma unroll
        for (int bj = 0; bj < 2; ++bj)
#pragma unroll
            for (int n = 0; n < 2; ++n) gv[bj][n] = *(const f32x4*)(gt + (size_t)b * MSTR + c0 + 128 * bj + 4 * n);
        u32x4 cur[2], nxt[2];
        { const size_t off = (size_t)rl0 * D + c0;
#pragma unroll
          for (int bj = 0; bj < 2; ++bj) cur[bj] = *(const u32x4*)(xin + off + 128 * bj); }
        LAS float* P = (LAS float*)lds; LAS float* S = (LAS float*)(lds + 4096);
#pragma unroll
        for (int g = 0; g < 8; ++g) { const int ai = g >> 2, m = g & 3;
            if (g < 7) { const size_t offn = (size_t)(rl0 + ((g + 1) >> 2) * 128 + ((g + 1) & 3) * 16) * D + c0;
#pragma unroll
                for (int bj = 0; bj < 2; ++bj) nxt[bj] = *(const u32x4*)(xin + offn + 128 * bj); }
            float sq = 0.f;
#pragma unroll
            for (int bj = 0; bj < 2; ++bj) { f32x4 xc[2]; unpack8(cur[bj], xc[0], xc[1]);
#pragma unroll
                for (int n = 0; n < 2; ++n) { const f32x4 v = xc[n] + gv[bj][n] * acc[ai][bj][m][n]; acc[ai][bj][m][n] = v; sq += (v[0] * v[0] + v[1] * v[1]) + (v[2] * v[2] + v[3] * v[3]); } }
            sq += __shfl_xor(sq, 16); sq += __shfl_xor(sq, 32);
            if (fq == 0) P[(ai * 128 + wr * 64 + m * 16 + fr) * 4 + wc] = sq;
#pragma unroll
            for (int bj = 0; bj < 2; ++bj) cur[bj] = nxt[bj]; }
        asm volatile("s_waitcnt lgkmcnt(0)" ::: "memory"); __builtin_amdgcn_s_barrier(); asm volatile("" ::: "memory");
        const int tid = wid * 64 + lane;
        if (tid < 256) { const float bp = (P[tid * 4] + P[tid * 4 + 1]) + (P[tid * 4 + 2] + P[tid * 4 + 3]);
            __hip_atomic_store(xch + ((size_t)u.pm * 256 + tid) * 4 + u.pn, bp, __ATOMIC_RELAXED, __HIP_MEMORY_SCOPE_AGENT); }
        asm volatile("s_waitcnt vmcnt(0)" ::: "memory");
        if (tid < 256 && lane == 0) __hip_atomic_fetch_add(cnt + u.pm * 16, 1u, __ATOMIC_RELAXED, __HIP_MEMORY_SCOPE_AGENT);
        if (wid == 0) { unsigned spins = 0;
            while ((unsigned)__builtin_amdgcn_readfirstlane(__hip_atomic_load(cnt + u.pm * 16, __ATOMIC_RELAXED, __HIP_MEMORY_SCOPE_AGENT)) < 16u) { __builtin_amdgcn_s_sleep(2); if (++spins > (1u << 20)) break; }
            __builtin_amdgcn_fence(__ATOMIC_ACQUIRE, "agent"); asm volatile("s_waitcnt vmcnt(0)" ::: "memory"); }
        asm volatile("s_waitcnt vmcnt(0) lgkmcnt(0)" ::: "memory"); __builtin_amdgcn_s_barrier(); asm volatile("" ::: "memory");
        if (tid < 256) { const float* xr = xch + ((size_t)u.pm * 256 + tid) * 4;
            const float t = (__hip_atomic_load(xr, __ATOMIC_RELAXED, __HIP_MEMORY_SCOPE_AGENT) + __hip_atomic_load(xr + 1, __ATOMIC_RELAXED, __HIP_MEMORY_SCOPE_AGENT))
                          + (__hip_atomic_load(xr + 2, __ATOMIC_RELAXED, __HIP_MEMORY_SCOPE_AGENT) + __hip_atomic_load(xr + 3, __ATOMIC_RELAXED, __HIP_MEMORY_SCOPE_AGENT));
            S[tid] = rsqrtf(t * (1.f / D) + RMS_EPS); }
        asm volatile("s_waitcnt vmcnt(0) lgkmcnt(0)" ::: "memory"); __builtin_amdgcn_s_barrier(); asm volatile("" ::: "memory");
        f32x4 fgv[2][2];
#pragma unroll
        for (int bj = 0; bj < 2; ++bj)
#pragma unroll
            for (int n = 0; n < 2; ++n) fgv[bj][n] = *(const f32x4*)(fg + c0 + 128 * bj + 4 * n);
#pragma unroll
        for (int ai = 0; ai < 2; ++ai)
#pragma unroll
            for (int m = 0; m < 4; ++m) { const int lr = ai * 128 + wr * 64 + m * 16 + fr; const float r = S[lr]; float* orow = out + (size_t)(u.pm * 256 + lr) * D + c0;
#pragma unroll
                for (int bj = 0; bj < 2; ++bj)
#pragma unroll
                    for (int n = 0; n < 2; ++n) *(f32x4*)(orow + 128 * bj + 4 * n) = acc[ai][bj][m][n] * r * fgv[bj][n]; }
    }
};
struct EpiResNorm {
    static constexpr bool AFTER_DRAIN = true, TRANSFORM = false;
    unsigned char* arena; const float* x; const float* mod; const float* g2; float* xch; unsigned* cnt;
    __device__ __forceinline__ void fused(f32x4 (&acc)[2][2][4][2], const pg8::Unit& u, int wr, int wc, int fr, int fq, LAS unsigned char* lds, int wid, int lane) const {
        EPI_ROWS; const int c0 = 256 * u.pn + wc * 32 + fq * 8, b = u.pm >> 3; const float* mb = mod + (size_t)b * MSTR;
        const float* xin = x + (size_t)b * SEQ * D; bf16_t* x1 = (bf16_t*)(ab + AO_X1); bf16_t* H2 = (bf16_t*)(ab + AO_A1);
        LAS float* P = (LAS float*)lds; LAS float* S = (LAS float*)(lds + 4096);
        { f32x4 gv[2][2], cur[2][2], nxt[2][2];
#pragma unroll
          for (int bj = 0; bj < 2; ++bj)
#pragma unroll
              for (int n = 0; n < 2; ++n) gv[bj][n] = *(const f32x4*)(mb + MO_GT1 + c0 + 128 * bj + 4 * n);
          { const size_t off = (size_t)rl0 * D + c0;
#pragma unroll
            for (int bj = 0; bj < 2; ++bj)
#pragma unroll
                for (int n = 0; n < 2; ++n) cur[bj][n] = *(const f32x4*)(xin + off + 128 * bj + 4 * n); }
#pragma unroll
          for (int g = 0; g < 8; ++g) { const int ai = g >> 2, m = g & 3;
              if (g < 7) { const size_t offn = (size_t)(rl0 + ((g + 1) >> 2) * 128 + ((g + 1) & 3) * 16) * D + c0;
#pragma unroll
                  for (int bj = 0; bj < 2; ++bj)
#pragma unroll
                      for (int n = 0; n < 2; ++n) nxt[bj][n] = *(const f32x4*)(xin + offn + 128 * bj + 4 * n); }
              float sq = 0.f;
#pragma unroll
              for (int bj = 0; bj < 2; ++bj)
#pragma unroll
                  for (int n = 0; n < 2; ++n) { const f32x4 v = cur[bj][n] + gv[bj][n] * acc[ai][bj][m][n]; acc[ai][bj][m][n] = v; sq += (v[0] * v[0] + v[1] * v[1]) + (v[2] * v[2] + v[3] * v[3]); }
              sq += __shfl_xor(sq, 16); sq += __shfl_xor(sq, 32);
              if (fq == 0) P[(ai * 128 + wr * 64 + m * 16 + fr) * 4 + wc] = sq;
#pragma unroll
              for (int bj = 0; bj < 2; ++bj)
#pragma unroll
                  for (int n = 0; n < 2; ++n) cur[bj][n] = nxt[bj][n]; } }
        asm volatile("s_waitcnt lgkmcnt(0)" ::: "memory"); __builtin_amdgcn_s_barrier(); asm volatile("" ::: "memory");
        const int tid = wid * 64 + lane;
        if (tid < 256) { const float bp = (P[tid * 4] + P[tid * 4 + 1]) + (P[tid * 4 + 2] + P[tid * 4 + 3]);
            __hip_atomic_store(xch + ((size_t)u.pm * 256 + tid) * 4 + u.pn, bp, __ATOMIC_RELAXED, __HIP_MEMORY_SCOPE_AGENT); }
        asm volatile("s_waitcnt vmcnt(0)" ::: "memory");
        if (tid < 256 && lane == 0) __hip_atomic_fetch_add(cnt + u.pm * 16, 1u, __ATOMIC_RELAXED, __HIP_MEMORY_SCOPE_AGENT);
        if (wid == 0) { unsigned spins = 0;
            while ((unsigned)__builtin_amdgcn_readfirstlane(__hip_atomic_load(cnt + u.pm * 16, __ATOMIC_RELAXED, __HIP_MEMORY_SCOPE_AGENT)) < 16u) { __builtin_amdgcn_s_sleep(2); if (++spins > (1u << 20)) break; }
            __builtin_amdgcn_fence(__ATOMIC_ACQUIRE, "agent"); asm volatile("s_waitcnt vmcnt(0)" ::: "memory"); }
        asm volatile("s_waitcnt vmcnt(0) lgkmcnt(0)" ::: "memory"); __builtin_amdgcn_s_barrier(); asm volatile("" ::: "memory");
        if (tid < 256) { const float* xr = xch + ((size_t)u.pm * 256 + tid) * 4;
            const float t = (__hip_atomic_load(xr, __ATOMIC_RELAXED, __HIP_MEMORY_SCOPE_AGENT) + __hip_atomic_load(xr + 1, __ATOMIC_RELAXED, __HIP_MEMORY_SCOPE_AGENT))
                          + (__hip_atomic_load(xr + 2, __ATOMIC_RELAXED, __HIP_MEMORY_SCOPE_AGENT) + __hip_atomic_load(xr + 3, __ATOMIC_RELAXED, __HIP_MEMORY_SCOPE_AGENT));
            S[tid] = rsqrtf(t * (1.f / D) + RMS_EPS); }
        asm volatile("s_waitcnt vmcnt(0) lgkmcnt(0)" ::: "memory"); __builtin_amdgcn_s_barrier(); asm volatile("" ::: "memory");
        f32x4 mul[2][2], sh[2][2];
#pragma unroll
        for (int bj = 0; bj < 2; ++bj)
#pragma unroll
            for (int n = 0; n < 2; ++n) { const int col = c0 + 128 * bj + 4 * n; const f32x4 gg = *(const f32x4*)(g2 + col), sc = *(const f32x4*)(mb + MO_SC2 + col);
                sh[bj][n] = *(const f32x4*)(mb + MO_SH2 + col); mul[bj][n] = gg * (sc + 1.0f); }
#pragma unroll
        for (int ai = 0; ai < 2; ++ai)
#pragma unroll
            for (int m = 0; m < 4; ++m) { const int lr = ai * 128 + wr * 64 + m * 16 + fr; const float r = S[lr]; const size_t off = (size_t)(rl0 + ai * 128 + m * 16) * D + c0;
#pragma unroll
                for (int bj = 0; bj < 2; ++bj) {
                    *(u32x4*)(x1 + off + 128 * bj) = pack8(acc[ai][bj][m][0], acc[ai][bj][m][1]);
                    *(u32x4*)(H2 + off + 128 * bj) = pack8(acc[ai][bj][m][0] * r * mul[bj][0] + sh[bj][0], acc[ai][bj][m][1] * r * mul[bj][1] + sh[bj][1]); } }
    }
};
struct EpiGU {
    static constexpr bool AFTER_DRAIN = false, TRANSFORM = false;
    unsigned char* arena;
    __device__ __forceinline__ void operator()(AccRef acc, const pg8::Unit& u, int wr, int wc, int fr, int fq) const {
        EPI_ROWS; const int cA = 128 * u.pn + wc * 32 + fq * 8; bf16_t* ACT = (bf16_t*)(ab + AO_ACT);
#pragma unroll
        for (int ai = 0; ai < 2; ++ai)
#pragma unroll
            for (int m = 0; m < 4; ++m) { f32x4 r[2];
#pragma unroll
                for (int n = 0; n < 2; ++n) { const f32x4 a = acc[ai][0][m][n], b = acc[ai][1][m][n];
#pragma unroll
                    for (int j = 0; j < 4; ++j) r[n][j] = a[j] * sigm(a[j]) * b[j]; }
                *(u32x4*)(ACT + (size_t)(rl0 + ai * 128 + m * 16) * DFF + cA) = pack8(r[0], r[1]); }
    }
};

__device__ __forceinline__ void p0_mod(const Args& a, float* mod, LAS unsigned char* lds, int item, int tid, int lane, int wave) {
    LAS float* cs = (LAS float*)lds; LAS float* red = (LAS float*)(lds + 32768);
    for (int i = tid; i < NB * D; i += 512) { const int b = i >> 10, k = i & 1023; const float v = a.c[i]; cs[k * 8 + b] = v * sigm(v); }
    __syncthreads();
    const int jl = lane & 31, j = item * 32 + jl, kg = wave * 2 + (lane >> 5);
    float s0 = 0.f, s1 = 0.f, s2 = 0.f, s3 = 0.f, s4 = 0.f, s5 = 0.f, s6 = 0.f, s7 = 0.f;
#pragma unroll 16
    for (int kk = 0; kk < 64; ++kk) { const int k = kg * 64 + kk; const float w = a.w_ada[(size_t)k * NMOD + j];
        const f32x4 c0 = *(const LAS f32x4*)(cs + k * 8), c1 = *(const LAS f32x4*)(cs + k * 8 + 4);
        s0 += w * c0[0]; s1 += w * c0[1]; s2 += w * c0[2]; s3 += w * c0[3]; s4 += w * c1[0]; s5 += w * c1[1]; s6 += w * c1[2]; s7 += w * c1[3]; }
    red[(kg * 8 + 0) * 32 + jl] = s0; red[(kg * 8 + 1) * 32 + jl] = s1; red[(kg * 8 + 2) * 32 + jl] = s2; red[(kg * 8 + 3) * 32 + jl] = s3;
    red[(kg * 8 + 4) * 32 + jl] = s4; red[(kg * 8 + 5) * 32 + jl] = s5; red[(kg * 8 + 6) * 32 + jl] = s6; red[(kg * 8 + 7) * 32 + jl] = s7;
    __syncthreads();
    if (tid < 256) { const int b = tid >> 5, jj = tid & 31; float s = 0.f;
#pragma unroll
        for (int g = 0; g < 16; ++g) s += red[(g * 8 + b) * 32 + jj];
        mod[(size_t)b * MSTR + item * 32 + jj] = s + a.b_ada[item * 32 + jj]; }
    __syncthreads();
}
__device__ __forceinline__ void p0_mod_ksplit(const Args& a, float* part, LAS unsigned char* lds, int item, int tid, int lane, int wave) {
    LAS float* cs = (LAS float*)lds; LAS float* red = (LAS float*)(lds + 4096);
    const int g = item >> 3, kc = item & 7;
    for (int i = tid; i < 128 * NB; i += 512) { const int b = i >> 7, k = i & 127; const float v = a.c[b * D + kc * 128 + k]; cs[k * 8 + b] = v * sigm(v); }
    f32x4 wv[16];
#pragma unroll
    for (int i = 0; i < 16; ++i) wv[i] = *(const f32x4*)(a.w_ada + (size_t)(kc * 128 + wave * 16 + i) * NMOD + g * 256 + 4 * lane);
    __syncthreads();
    f32x4 acc[8];
#pragma unroll
    for (int b = 0; b < 8; ++b) acc[b] = (f32x4){0.f, 0.f, 0.f, 0.f};
#pragma unroll
    for (int i = 0; i < 16; ++i) { const int k = wave * 16 + i; const f32x4 c0 = *(const LAS f32x4*)(cs + k * 8), c1 = *(const LAS f32x4*)(cs + k * 8 + 4);
        acc[0] += wv[i] * c0[0]; acc[1] += wv[i] * c0[1]; acc[2] += wv[i] * c0[2]; acc[3] += wv[i] * c0[3];
        acc[4] += wv[i] * c1[0]; acc[5] += wv[i] * c1[1]; acc[6] += wv[i] * c1[2]; acc[7] += wv[i] * c1[3]; }
#pragma unroll
    for (int b = 0; b < 8; ++b) *(LAS f32x4*)(red + (wave * 8 + b) * 256 + 4 * lane) = acc[b];
    __syncthreads();
    { const int b = tid >> 6, c4 = tid & 63; f32x4 sacc = (f32x4){0.f, 0.f, 0.f, 0.f};
#pragma unroll
      for (int w = 0; w < 8; ++w) sacc += *(const LAS f32x4*)(red + (w * 8 + b) * 256 + 4 * c4);
      *(f32x4*)(part + ((size_t)kc * NB + b) * NMOD + g * 256 + 4 * c4) = sacc; }
    __syncthreads();
}
__device__ __forceinline__ void transpose_item(const float* W, int K, int N, bf16_t* WT, int k0, int nsrc0, int rdst0, LAS float* scr, int lane) {
    { float tv[32];
#pragma unroll
      for (int i = 0; i < 32; ++i) { const int kk = 2 * i + (lane >> 5); tv[i] = W[(size_t)(k0 + kk) * N + nsrc0 + (lane & 31)]; }
#pragma unroll
      for (int i = 0; i < 32; ++i) { const int kk = 2 * i + (lane >> 5); scr[kk * 33 + (lane & 31)] = tv[i]; } }
    asm volatile("s_waitcnt lgkmcnt(0)" ::: "memory");
    const int c = lane & 7;
#pragma unroll
    for (int j = 0; j < 4; ++j) { const int n = (lane >> 3) + 8 * j; const LAS float* s = scr + (8 * c) * 33 + n;
        u32x4 o; o.x = cvt_pk_bf16(s[0 * 33], s[1 * 33]); o.y = cvt_pk_bf16(s[2 * 33], s[3 * 33]); o.z = cvt_pk_bf16(s[4 * 33], s[5 * 33]); o.w = cvt_pk_bf16(s[6 * 33], s[7 * 33]);
        *(u32x4*)(WT + (size_t)(rdst0 + n) * K + k0 + 8 * c) = o; }
    asm volatile("s_waitcnt lgkmcnt(0)" ::: "memory");
}
__device__ __forceinline__ void p0_convert_win_block(const Args& a, unsigned char* ws, LAS unsigned char* lds, int bitem, int lane, int wave) {
    LAS float* tile = (LAS float*)lds; bf16_t* WT = (bf16_t*)(ws + WS_WIN);
    const int kb = bitem / (DIN / 256), nbt = bitem % (DIN / 256), k0 = 64 * kb, h = lane >> 5, c4 = lane & 31;
    const int src0 = map_in(256 * nbt + 128 * h) + 4 * c4;
    f32x4 v[8];
#pragma unroll
    for (int i = 0; i < 8; ++i) v[i] = *(const f32x4*)(a.w_in + (size_t)(k0 + wave * 8 + i) * DIN + src0);
#pragma unroll
    for (int i = 0; i < 8; ++i) *(LAS f32x4*)(tile + (wave * 8 + i) * 260 + 128 * h + 4 * c4) = v[i];
    __syncthreads();
    const int c = lane & 7;
#pragma unroll
    for (int j = 0; j < 4; ++j) { const int n = wave * 32 + (lane >> 3) + 8 * j; const LAS float* sp = tile + (8 * c) * 260 + n;
        u32x4 o; o.x = cvt_pk_bf16(sp[0 * 260], sp[1 * 260]); o.y = cvt_pk_bf16(sp[2 * 260], sp[3 * 260]); o.z = cvt_pk_bf16(sp[4 * 260], sp[5 * 260]); o.w = cvt_pk_bf16(sp[6 * 260], sp[7 * 260]);
        *(u32x4*)(WT + (size_t)(256 * nbt + n) * D + k0 + 8 * c) = o; }
    __syncthreads();
}
constexpr int I_IN = (D / 64) * (DIN / 32), I_A = (DC / 64) * (D / 32), I_B = I_A, I_O = (D / 64) * (D / 32), I_GU = (D / 64) * (NGU / 32), I_DN = (DFF / 64) * (D / 32);
constexpr int NITEMS = I_IN + I_A + I_B + I_O + I_GU + I_DN;
__device__ __forceinline__ void p0_convert(const Args& a, unsigned char* ws, LAS unsigned char* lds, int gw, int NGW, int wave, int lane, int first, int last) {
    LAS float* scr = (LAS float*)(lds + 49152 + wave * 8448);
    for (int it = first + gw; it < last; it += NGW) {
        int r = it;
        if (r < I_IN) { const int nblk = DIN / 32, kb = r / nblk, nb = r % nblk; transpose_item(a.w_in, D, DIN, (bf16_t*)(ws + WS_WIN), 64 * kb, map_in(32 * nb), 32 * nb, scr, lane); continue; } r -= I_IN;
        if (r < I_A) { const int nblk = D / 32, kb = r / nblk, nb = r % nblk; transpose_item(a.conf_w_out, DC, D, (bf16_t*)(ws + WS_WA), 64 * kb, 32 * nb, 32 * nb, scr, lane); continue; } r -= I_A;
        if (r < I_B) { const int nblk = D / 32, kb = r / nblk, nb = r % nblk; transpose_item(a.sc_w_out, DC, D, (bf16_t*)(ws + WS_WB), 64 * kb, 32 * nb, 32 * nb, scr, lane); continue; } r -= I_B;
        if (r < I_O) { const int nblk = D / 32, kb = r / nblk, nb = r % nblk; transpose_item(a.w_o, D, D, (bf16_t*)(ws + WS_WO), 64 * kb, 32 * nb, 32 * nb, scr, lane); continue; } r -= I_O;
        if (r < I_GU) { const int nblk = NGU / 32, kb = r / nblk, nb = r % nblk; transpose_item(a.w_gu, D, NGU, (bf16_t*)(ws + WS_WGU), 64 * kb, map_gu(32 * nb), 32 * nb, scr, lane); continue; } r -= I_GU;
        { const int nblk = D / 32, kb = r / nblk, nb = r % nblk; transpose_item(a.w_down, DFF, D, (bf16_t*)(ws + WS_WDN), 64 * kb, 32 * nb, 32 * nb, scr, lane); }
    }
}
__device__ __forceinline__ float sumsq4(const f32x4 (&v)[4]) { float ss = 0.f;
#pragma unroll
    for (int j = 0; j < 4; ++j) ss += (v[j][0] * v[j][0] + v[j][1] * v[j][1]) + (v[j][2] * v[j][2] + v[j][3] * v[j][3]);
    return ss; }
__device__ __forceinline__ int own_row(int i, int wave, int G, int c) { return (G == 256) ? (c & 7) * SEQ + (c >> 3) * 64 + wave * 8 + i : (c * 8 + wave) + i * (G * 8); }
__device__ __forceinline__ int own_cnt(int G) { return (G == 256) ? 8 : (M + G * 8 - 1) / (G * 8); }
__device__ __forceinline__ const float* x1_row(unsigned char* arena, int m) { return (const float*)(arena + (size_t)(m >> 11) * ARENA + AO_X1) + (size_t)(m & (SEQ - 1)) * D; }
__device__ __forceinline__ void rownorm_mod(const float* xg, unsigned char* arena, const float* g, const float* mod, int sh_off, int sc_off, int wave, int G, int lane, int vid, const float* part = nullptr, const float* bias = nullptr) {
    const int cnt = own_cnt(G); int m = own_row(0, wave, G, vid); if (m >= M) return;
    f32x4 cur[4], nxt[4], mul[4], sh[4]; int bcur = -1;
    { const f32x4* xr = (const f32x4*)(xg ? xg + (size_t)m * D : x1_row(arena, m)) + lane;
#pragma unroll
      for (int j = 0; j < 4; ++j) cur[j] = xr[64 * j]; }
    for (int it = 0; it < cnt && m < M; ++it) { const int mn = (it + 1 < cnt) ? own_row(it + 1, wave, G, vid) : M;
        if (mn < M) { const f32x4* xr = (const f32x4*)(xg ? xg + (size_t)mn * D : x1_row(arena, mn)) + lane;
#pragma unroll
            for (int j = 0; j < 4; ++j) nxt[j] = xr[64 * j]; }
        const int b = m >> 11;
        if (b != bcur) { bcur = b;
#pragma unroll
            for (int j = 0; j < 4; ++j) { const int col = 4 * lane + 256 * j; const f32x4 gv = *(const f32x4*)(g + col); f32x4 sc;
                if (part) {
                    sc = *(const f32x4*)(bias + sc_off + col); sh[j] = *(const f32x4*)(bias + sh_off + col);
#pragma unroll
                    for (int kc = 0; kc < 8; ++kc) { const float* pp = part + ((size_t)kc * NB + b) * NMOD; sc += *(const f32x4*)(pp + sc_off + col); sh[j] += *(const f32x4*)(pp + sh_off + col); }
                } else { sc = *(const f32x4*)(mod + (size_t)b * MSTR + sc_off + col); sh[j] = *(const f32x4*)(mod + (size_t)b * MSTR + sh_off + col); }
                mul[j] = gv * (sc + 1.0f); } }
        const float rstd = rsqrtf(wave_sum(sumsq4(cur)) * (1.f / D) + RMS_EPS);
        u32x2* o8 = (u32x2*)((bf16_t*)(arena + (size_t)b * ARENA + AO_A1) + (size_t)(m & (SEQ - 1)) * D) + lane;
#pragma unroll
        for (int j = 0; j < 4; ++j) { const f32x4 o = cur[j] * rstd * mul[j] + sh[j]; u32x2 w; w.x = cvt_pk_bf16(o[0], o[1]); w.y = cvt_pk_bf16(o[2], o[3]); o8[64 * j] = w; }
#pragma unroll
        for (int j = 0; j < 4; ++j) cur[j] = nxt[j];
        m = mn; }
}
__device__ __forceinline__ void final_norm(unsigned char* arena, float* O, const float* g, int wave, int G, int lane, int vid) {
    f32x4 gv[4];
#pragma unroll
    for (int j = 0; j < 4; ++j) gv[j] = *(const f32x4*)(g + 4 * lane + 256 * j);
    const int cnt = own_cnt(G); f32x4 cur[4], nxt[4]; int m = own_row(0, wave, G, vid);
    if (m < M) { const f32x4* xr = (const f32x4*)x1_row(arena, m) + lane;
#pragma unroll
        for (int j = 0; j < 4; ++j) cur[j] = xr[64 * j]; }
    for (int it = 0; it < cnt && m < M; ++it) { const int mn = (it + 1 < cnt) ? own_row(it + 1, wave, G, vid) : M;
        if (mn < M) { const f32x4* xr = (const f32x4*)x1_row(arena, mn) + lane;
#pragma unroll
            for (int j = 0; j < 4; ++j) nxt[j] = xr[64 * j]; }
        const float rstd = rsqrtf(wave_sum(sumsq4(cur)) * (1.f / D) + RMS_EPS);
        f32x4* orow = (f32x4*)(O + (size_t)m * D) + lane;
#pragma unroll
        for (int j = 0; j < 4; ++j) orow[64 * j] = cur[j] * rstd * gv[j];
#pragma unroll
        for (int j = 0; j < 4; ++j) cur[j] = nxt[j];
        m = mn; }
}
__device__ __forceinline__ void p3_conv(const Args& a, unsigned char* arena, LAS unsigned char* lds, int tid, int lane, int wave, int vid) {
    LAS unsigned* buf = (LAS unsigned*)lds; LAS float* red = (LAS float*)(lds + 94 * 1024);
    const int cp = tid & 255, th = tid >> 8, w4 = wave & 3;
    f32x2 w[CONF_K];
#pragma unroll
    for (int k = 0; k < CONF_K; ++k) w[k] = *(const f32x2*)(a.conf_dw_w + k * DC + 2 * cp);
    const f32x2 cb = *(const f32x2*)(a.conf_dw_b + 2 * cp), lg = *(const f32x2*)(a.conf_ln_g + 2 * cp), lb = *(const f32x2*)(a.conf_ln_b + 2 * cp);
    const f32x2 w30 = *(const f32x2*)(a.sc_dw_w + 2 * cp), w31 = *(const f32x2*)(a.sc_dw_w + DC + 2 * cp), w32 = *(const f32x2*)(a.sc_dw_w + 2 * DC + 2 * cp);
    for (int tl = vid; tl < M / 64; tl += gridDim.x) {
        const int tile = (gridDim.x == 256) ? (tl & 7) * 32 + (tl >> 3) : tl;
        const int b = tile >> 5, t0 = (tile & 31) * 64;
        unsigned char* ab = arena + (size_t)b * ARENA;
        const bf16_t* U = (const bf16_t*)(ab + AO_U); const unsigned* GCV = (const unsigned*)(ab + AO_GCV); const unsigned* GBp = (const unsigned*)(ab + AO_GB);
        unsigned* UA = (unsigned*)(ab + AO_UA); unsigned* VB = (unsigned*)(ab + AO_VB);
        __syncthreads();
        { u32x4 sv[12];
#pragma unroll
          for (int i = 0; i < 12; ++i) { const int ch = tid + 512 * i, row = ch >> 6, c16 = ch & 63; sv[i] = (u32x4){0u, 0u, 0u, 0u};
              if (ch < 94 * 64 && (t0 != 0 || row >= 30)) sv[i] = *(const u32x4*)(U + (size_t)(t0 - 30 + row) * DC + c16 * 8); }
#pragma unroll
          for (int i = 0; i < 12; ++i) { const int ch = tid + 512 * i, row = ch >> 6, c16 = ch & 63; if (ch < 94 * 64) *(LAS u32x4*)(lds + row * 1024 + c16 * 16) = sv[i]; } }
        __syncthreads();
#pragma unroll 1
        for (int chunk = 0; chunk < 4; ++chunk) {
            const int tb = t0 + th * 32 + chunk * 8; unsigned gc[10], gbv[8];
            { const bool head = (tb == 0);
              gc[0] = head ? 0u : GCV[(size_t)(tb - 2) * (DC / 2) + cp]; gc[1] = head ? 0u : GCV[(size_t)(tb - 1) * (DC / 2) + cp];
#pragma unroll
              for (int tt = 0; tt < 8; ++tt) { gc[2 + tt] = GCV[(size_t)(tb + tt) * (DC / 2) + cp]; gbv[tt] = GBp[(size_t)(tb + tt) * (DC / 2) + cp]; } }
            float y0[8], y1[8];
#pragma unroll
            for (int tt = 0; tt < 8; ++tt) { const int lt = th * 32 + chunk * 8 + tt; float a0 = cb[0], a1 = cb[1];
#pragma unroll
                for (int k = 0; k < CONF_K; ++k) { const unsigned v = buf[(lt + k) * 256 + cp]; a0 += w[k][0] * bf_lo(v); a1 += w[k][1] * bf_hi(v); }
                y0[tt] = a0; y1[tt] = a1; }
#pragma unroll
            for (int tt = 0; tt < 8; ++tt) { const float sq = wave_sum(y0[tt] + y1[tt]), q = wave_sum(y0[tt] * y0[tt] + y1[tt] * y1[tt]);
                if (lane == 0) { red[((tt * 2 + th) * 4 + w4) * 2 + 0] = sq; red[((tt * 2 + th) * 4 + w4) * 2 + 1] = q; } }
            __syncthreads();
#pragma unroll
            for (int tt = 0; tt < 8; ++tt) { const int lt = th * 32 + chunk * 8 + tt; const LAS float* r = red + (tt * 2 + th) * 8;
                const float S = (r[0] + r[2]) + (r[4] + r[6]), Q = (r[1] + r[3]) + (r[5] + r[7]);
                const float mean = S * (1.f / DC), var = fmaxf(Q * (1.f / DC) - mean * mean, 0.f), rstd = rsqrtf(var + LN_EPS);
                const float z0 = (y0[tt] - mean) * rstd * lg[0] + lb[0], z1 = (y1[tt] - mean) * rstd * lg[1] + lb[1];
                UA[(size_t)(t0 + lt) * (DC / 2) + cp] = cvt_pk_bf16(z0 * sigm(z0), z1 * sigm(z1)); }
#pragma unroll
            for (int tt = 0; tt < 8; ++tt) { const unsigned p2 = gc[tt], p1 = gc[tt + 1], cur = gc[tt + 2], gb = gbv[tt];
                const float r0 = w30[0] * bf_lo(p2) + w31[0] * bf_lo(p1) + w32[0] * bf_lo(cur), r1 = w30[1] * bf_hi(p2) + w31[1] * bf_hi(p1) + w32[1] * bf_hi(cur);
                VB[(size_t)(tb + tt) * (DC / 2) + cp] = cvt_pk_bf16(bf_lo(gb) * r0, bf_hi(gb) * r1); }
            __syncthreads();
        }
    }
}

__global__ void __launch_bounds__(512, 2) mega(Args a) {
    extern __shared__ __attribute__((aligned(16))) unsigned char lds_raw[];
    LAS unsigned char* lds = (LAS unsigned char*)lds_raw;
    const int G = gridDim.x;
#define PHASE_IDS const int tid = opaque_tid(), lane = tid & 63, wave = __builtin_amdgcn_readfirstlane(tid >> 6); (void)tid; (void)lane; (void)wave
    unsigned char* ws = a.ws; unsigned char* arena = ws + WS_ARENA; float* mod = (float*)(arena + AO_MODX); float* modp = (float*)(ws + WS_MODP);
    volatile LAS unsigned* misc = (volatile LAS unsigned*)(lds + 131072);
    unsigned* ctl = (unsigned*)ws;
#define VID ((int)misc[2])
#define GRID_BARRIER(idx) do { asm volatile("s_waitcnt vmcnt(0) lgkmcnt(0)" ::: "memory"); __syncthreads(); \
        if (threadIdx.x == 0) { unsigned* bw = ctl + 1024 + 64 * (idx); __builtin_amdgcn_fence(__ATOMIC_RELEASE, "agent"); asm volatile("s_waitcnt vmcnt(0)" ::: "memory"); \
            __hip_atomic_fetch_add(bw, 1u, __ATOMIC_RELAXED, __HIP_MEMORY_SCOPE_AGENT); \
            while (__hip_atomic_load(bw, __ATOMIC_RELAXED, __HIP_MEMORY_SCOPE_AGENT) < gridDim.x) __builtin_amdgcn_s_sleep(1); \
            __builtin_amdgcn_fence(__ATOMIC_ACQUIRE, "agent"); asm volatile("s_waitcnt vmcnt(0)" ::: "memory"); } \
        __syncthreads(); asm volatile("" ::: "memory"); } while (0)
#define SEAM(k) do { if (misc[3] != 0u) { asm volatile("s_waitcnt vmcnt(0) lgkmcnt(0)" ::: "memory"); __syncthreads(); \
            if (threadIdx.x == 0) { unsigned* bw = ctl + 2048 + 64 * misc[0] + (k); __hip_atomic_fetch_add(bw, 1u, __ATOMIC_RELAXED, __HIP_MEMORY_SCOPE_AGENT); \
                while (__hip_atomic_load(bw, __ATOMIC_RELAXED, __HIP_MEMORY_SCOPE_AGENT) < 32u) __builtin_amdgcn_s_sleep(1); \
                __builtin_amdgcn_fence(__ATOMIC_ACQUIRE, "agent"); asm volatile("s_waitcnt vmcnt(0)" ::: "memory"); } \
            __syncthreads(); asm volatile("" ::: "memory"); } else GRID_BARRIER(k); } while (0)

    if (threadIdx.x == 0) { const unsigned xcc = (unsigned)__builtin_amdgcn_s_getreg((3 << 11) | 20) & 0xFu;
        misc[0] = xcc; misc[1] = __hip_atomic_fetch_add(ctl + 64 * xcc, 1u, __ATOMIC_RELAXED, __HIP_MEMORY_SCOPE_AGENT); misc[2] = blockIdx.x; misc[3] = 0u; }

    { PHASE_IDS; const int gw = ((G == 256) ? (int)((blockIdx.x + 64u) & 255u) : (int)blockIdx.x) * 8 + wave, NGW = G * 8;
        if (G == 256) { if (blockIdx.x < 192) p0_mod_ksplit(a, modp, lds, blockIdx.x, tid, lane, wave); }
        else if (G > 256) { if (blockIdx.x < 192) p0_mod(a, mod, lds, blockIdx.x, tid, lane, wave); }
        else { for (int it = blockIdx.x; it < 192; it += G) p0_mod(a, mod, lds, it, tid, lane, wave); }
        if (G == 256) {
            p0_convert_win_block(a, ws, lds, (int)blockIdx.x, lane, wave);
            if (blockIdx.x >= 224) p0_convert_win_block(a, ws, lds, 256 + (int)blockIdx.x - 224, lane, wave);
        } else p0_convert(a, ws, lds, gw, NGW, wave, lane, 0, NITEMS);
    }
    if (gridDim.x == 0xFFFFFFFFu) cg::this_grid().sync();
    GRID_BARRIER(0);
    if (threadIdx.x == 0) {
        bool even = (G == 256);
        for (int j = 0; j < 16; ++j) { const unsigned cnt = __hip_atomic_load(ctl + 64 * j, __ATOMIC_RELAXED, __HIP_MEMORY_SCOPE_AGENT); if (cnt != (j < 8 ? 32u : 0u)) even = false; }
        if (even) { misc[2] = misc[1] * 8u + misc[0]; misc[3] = 1u; } }
    __syncthreads();

    if (G == 256) { PHASE_IDS; const int vid = VID, b = vid & 7, col = (vid >> 3) * 192 + tid;
        if (tid < 192) { float sv = a.b_ada[col];
#pragma unroll
            for (int kc = 0; kc < 8; ++kc) sv += modp[((size_t)kc * NB + b) * NMOD + col];
            mod[(size_t)b * MSTR + col] = sv; }
        rownorm_mod(a.x, arena, a.norm1_g, mod, MO_SH1, MO_SC1, wave, G, lane, vid, modp, a.b_ada);
    } else { PHASE_IDS; rownorm_mod(a.x, arena, a.norm1_g, mod, MO_SH1, MO_SC1, wave, G, lane, VID); }
    SEAM(1);
    { pg8::Gemm g{arena, (unsigned)AO_A1, 0u, (const bf16_t*)(ws + WS_WIN), nullptr, D}; pg8::Order S; S.init(M, DIN, G, VID, 0);
      EpiIn E{arena, a.b_glu, a.b_gate}; pg8::gemm_phase(lds, g, S, E); }
    if (G == 256 && VID >= 128) { PHASE_IDS;
        p0_convert(a, ws, lds, (VID - 128) * 8 + wave, 1024, wave, lane, I_IN, NITEMS);
        asm volatile("s_waitcnt vmcnt(0) lgkmcnt(0)" ::: "memory"); __syncthreads();
        if (threadIdx.x == 0) { __builtin_amdgcn_fence(__ATOMIC_RELEASE, "agent"); asm volatile("s_waitcnt vmcnt(0)" ::: "memory");
            __hip_atomic_fetch_add(ctl + 1792, 1u, __ATOMIC_RELAXED, __HIP_MEMORY_SCOPE_AGENT); } }
    SEAM(2);
    { PHASE_IDS; p3_conv(a, arena, lds, tid, lane, wave, VID); }
    if (G == 256 && threadIdx.x == 0) { unsigned spins = 0;
        while (__hip_atomic_load(ctl + 1792, __ATOMIC_RELAXED, __HIP_MEMORY_SCOPE_AGENT) < 128u) { __builtin_amdgcn_s_sleep(2); if (++spins > (1u << 20)) break; } }
    SEAM(3);
    { pg8::Gemm g{arena, (unsigned)AO_UA, (unsigned)AO_VB, (const bf16_t*)(ws + WS_WA), (const bf16_t*)(ws + WS_WB), DC}; pg8::Order S; S.init(M, D, G, VID, 1);
      EpiDual E{arena, a.conf_b_out}; pg8::gemm_phase<false>(lds, g, S, E); }
    SEAM(4);
    if (G == 256) {
        pg8::Gemm g{arena, (unsigned)AO_MIX, 0u, (const bf16_t*)(ws + WS_WO), nullptr, D}; pg8::Order S; S.init(M, D, G, VID, 0);
        EpiResNorm E{arena, a.x, mod, a.norm2_g, (float*)(ws + WS_XCH + 512 * 1024), ctl + 6144}; pg8::gemm_phase(lds, g, S, E);
        SEAM(5);
    } else {
        { pg8::Gemm g{arena, (unsigned)AO_MIX, 0u, (const bf16_t*)(ws + WS_WO), nullptr, D}; pg8::Order S; S.init(M, D, G, VID, 0);
          EpiRes<true> E{arena, a.x, mod + MO_GT1}; pg8::gemm_phase(lds, g, S, E); }
        SEAM(5);
        { PHASE_IDS; rownorm_mod(nullptr, arena, a.norm2_g, mod, MO_SH2, MO_SC2, wave, G, lane, VID); }
        SEAM(6);
    }
    { pg8::Gemm g{arena, (unsigned)AO_A1, 0u, (const bf16_t*)(ws + WS_WGU), nullptr, D}; pg8::Order S; S.init(M, NGU, G, VID, 0);
      EpiGU E{arena}; pg8::gemm_phase(lds, g, S, E); }
    SEAM(7);
    if (G == 256) {
        pg8::Gemm g{arena, (unsigned)AO_ACT, 0u, (const bf16_t*)(ws + WS_WDN), nullptr, DFF}; pg8::Order S; S.init(M, D, G, VID, 0);
        EpiFinal E{arena, mod + MO_GT2, a.final_g, a.out, (float*)(ws + WS_XCH), ctl + 4096}; pg8::gemm_phase(lds, g, S, E);
    } else {
        { pg8::Gemm g{arena, (unsigned)AO_ACT, 0u, (const bf16_t*)(ws + WS_WDN), nullptr, DFF}; pg8::Order S; S.init(M, D, G, VID, 0);
          EpiRes<false> E{arena, nullptr, mod + MO_GT2}; pg8::gemm_phase(lds, g, S, E); }
        SEAM(8);
        { PHASE_IDS; final_norm(arena, a.out, a.final_g, wave, G, lane, VID); }
    }
#undef SEAM
#undef GRID_BARRIER
#undef VID
#undef PHASE_IDS
}

extern "C" void kernel_launch(void* const* d_in, const int* in_sizes, int n_in, void* d_out, int out_size, void* d_ws, size_t ws_size, hipStream_t stream) {
    static int grid = 0;
    if (grid == 0) {
        if (n_in != 21 || out_size != M * D || ws_size < WS_END) { fprintf(stderr, "kernel_launch: unexpected shapes (n_in %d out %d ws %zu)\n", n_in, out_size, ws_size); grid = -1; return; }
        int dev = 0, cus = 0, per_cu = 0;
        (void)hipGetDevice(&dev); (void)hipDeviceGetAttribute(&cus, hipDeviceAttributeMultiprocessorCount, dev);
        if (hipFuncSetAttribute((const void*)mega, hipFuncAttributeMaxDynamicSharedMemorySize, LDS_BYTES) != hipSuccess) { fprintf(stderr, "kernel_launch: hipFuncSetAttribute failed\n"); grid = -1; return; }
        if (hipOccupancyMaxActiveBlocksPerMultiprocessor(&per_cu, (const void*)mega, 512, LDS_BYTES) != hipSuccess || per_cu < 1) { fprintf(stderr, "kernel_launch: occupancy query gave %d\n", per_cu); per_cu = 1; }
        (void)hipGetLastError();
        grid = cus * per_cu;
    }
    if (grid < 0) return;
    Args a{};
    const float** ap = (const float**)&a;
    for (int i = 0; i < 21; ++i) ap[i] = (const float*)d_in[i];
    a.out = (float*)d_out; a.ws = (unsigned char*)d_ws; a.ph_lo = 0; a.ph_hi = 10;
    (void)hipMemsetAsync(d_ws, 0, 32768, stream);
    void* args[] = {&a};
    hipError_t e = hipLaunchCooperativeKernel((const void*)mega, dim3(grid), dim3(512), args, LDS_BYTES, stream);
    if (e != hipSuccess) fprintf(stderr, "cooperative launch failed: %s (grid %d)\n", hipGetErrorString(e), grid);
}
```
